# Optimizing an MI355X kernel written in HIP

```python
import jax, jax.numpy as jnp
from jax import lax
import numpy as np

D_MODEL = 2048
BATCH = 4
SEQ = 4096
DEPTH = 2

RET_HEADS = 4
RET_HEAD_DIM = 256
RET_WIDTH = RET_HEADS * RET_HEAD_DIM
RET_CHUNK = 128
RET_ROPE_BASE = 10000.0
MOBA_HEADS = 8
MOBA_HEAD_DIM = 128
MOBA_WIDTH = MOBA_HEADS * MOBA_HEAD_DIM
MOBA_BLOCK = 256
MOBA_TOPK = 3
MOBA_QCHUNK = 64
ROPE_THETA = 500000.0
ROPE_DIM = MOBA_HEAD_DIM // 4
HGRN_HEADS = 8
HGRN_HEAD_DIM = 128
HGRN_WIDTH = HGRN_HEADS * HGRN_HEAD_DIM
HGRN_CHUNK = 64
FFN_HIDDEN = ((8 * D_MODEL + 3 * 256 - 1) // (3 * 256)) * 256
NORM_EPS = 1e-6
IN_SIZES = (RET_WIDTH,) * 4 + (MOBA_WIDTH,) * 3 + (HGRN_WIDTH,) * 4 + (D_MODEL,) * 3
IN_COLS = sum(IN_SIZES)
IN_SPLITS = tuple(sum(IN_SIZES[:i + 1]) for i in range(len(IN_SIZES) - 1))

kernel_name = "hybrid_retention_moba_hgrn2_block"


def rmsnorm(x, g):
    xf = x.astype(jnp.float32)
    y = xf * lax.rsqrt(jnp.mean(xf * xf, axis=-1, keepdims=True) + NORM_EPS)
    return (y * g.astype(jnp.float32)).astype(x.dtype)


def head_layer_norm(o):
    mu = jnp.mean(o, axis=-1, keepdims=True)
    c = o - mu
    return c * lax.rsqrt(jnp.mean(c * c, axis=-1, keepdims=True) + NORM_EPS)


def head_rms_norm(o):
    return o * lax.rsqrt(jnp.mean(o * o, axis=-1, keepdims=True) + NORM_EPS)


def split_heads(t, n_heads):
    B, S, W = t.shape
    return t.reshape(B, S, n_heads, W // n_heads).transpose(0, 2, 1, 3)


def merge_heads(t):
    B, H, S, d = t.shape
    return t.transpose(0, 2, 1, 3).reshape(B, S, H * d)


def rotary(x, positions, rot_dim, base):
    half = rot_dim // 2
    inv_freq = base ** (-jnp.arange(half, dtype=jnp.float32) * 2.0 / rot_dim)
    ang = positions.astype(jnp.float32)[:, None] * inv_freq[None, :]
    cos = jnp.cos(ang).astype(x.dtype)
    sin = jnp.sin(ang).astype(x.dtype)
    x1 = x[..., :half]
    x2 = x[..., half:rot_dim]
    return jnp.concatenate([x1 * cos - x2 * sin, x2 * cos + x1 * sin, x[..., rot_dim:]], axis=-1)


def retention(q, k, v):
    B, H, S, dk = q.shape
    C = RET_CHUNK
    NC = S // C
    log_gamma = jnp.log1p(-jnp.exp2(-5.0 - jnp.arange(H, dtype=jnp.float32)))
    k = k * (dk ** -0.5)
    qc = q.reshape(B, H, NC, C, dk)
    kc = k.reshape(B, H, NC, C, dk)
    vc = v.reshape(B, H, NC, C, -1)
    t = jnp.arange(C, dtype=jnp.float32)
    rel = t[:, None] - t[None, :]
    decay = jnp.where(rel >= 0, jnp.exp(log_gamma[:, None, None] * jnp.maximum(rel, 0.0)), 0.0)
    scores = jnp.einsum('bhnid,bhnjd->bhnij', qc, kc) * decay[None, :, None]
    intra = jnp.einsum('bhnij,bhnje->bhnie', scores, vc)
    k_w = kc * jnp.exp(log_gamma[:, None] * (C - 1.0 - t))[None, :, None, :, None]
    kv = jnp.einsum('bhncd,bhnce->nbhde', k_w, vc)
    chunk_decay = jnp.exp(log_gamma * C)[None, :, None, None]

    def step(state, kv_n):
        return chunk_decay * state + kv_n, state

    _, r_prev = lax.scan(step, jnp.zeros_like(kv[0]), kv)
    q_w = qc * jnp.exp(log_gamma[:, None] * (t + 1.0))[None, :, None, :, None]
    cross = jnp.einsum('bhncd,nbhde->bhnce', q_w, r_prev)
    return (intra + cross).reshape(B, H, S, -1)


def moba_attention(q, k, v):
    B, H, S, d = q.shape
    L = MOBA_BLOCK
    QC = MOBA_QCHUNK
    NQ = S // QC
    pad = (-S) % L
    k_p = jnp.pad(k, ((0, 0), (0, 0), (0, pad), (0, 0)))
    v_p = jnp.pad(v, ((0, 0), (0, 0), (0, pad), (0, 0)))
    NB = (S + pad) // L
    K = min(MOBA_TOPK, NB)
    scale = d ** -0.5
    kb = k_p.reshape(B, H, NB, L, d)
    vb = v_p.reshape(B, H, NB, L, d)
    k_mean = jnp.mean(kb.astype(jnp.float32), axis=3)
    q_block = jnp.arange(S) // L
    gate = jnp.einsum('bhsd,bhnd->bhsn', q.astype(jnp.float32), k_mean)
    fully_past = jnp.arange(NB)[None, :] < q_block[:, None]
    gate = jnp.where(fully_past, gate, -jnp.inf)
    _, sel = lax.top_k(gate, K)
    valid = sel < q_block[:, None]

    def to_qchunks(t):
        t = t.reshape((B, H, NQ, QC) + t.shape[3:])
        t = jnp.swapaxes(t, 1, 2)
        return t.reshape((B * NQ, H, QC) + t.shape[4:])

    b_idx = jnp.repeat(jnp.arange(B), NQ)
    c_idx = jnp.tile(jnp.arange(NQ), B)
    h_idx = jnp.arange(H)[:, None, None]

    def attend(xs):
        qn, seln, validn, bi, ci = xs
        kbb = kb[bi]
        vbb = vb[bi]
        k_sel = kbb[h_idx, seln]
        v_sel = vbb[h_idx, seln]
        s_sel = jnp.einsum('hqd,hqkld->hqkl', qn, k_sel).astype(jnp.float32) * scale
        s_sel = jnp.where(validn[..., None], s_sel, -jnp.inf).reshape(H, QC, K * L)
        j = (ci * QC) // L
        k_own = kbb[:, j]
        v_own = vbb[:, j]
        q_pos = ci * QC + jnp.arange(QC)
        key_pos = j * L + jnp.arange(L)
        s_own = jnp.einsum('hqd,hld->hql', qn, k_own).astype(jnp.float32) * scale
        s_own = jnp.where(key_pos[None, None, :] <= q_pos[None, :, None], s_own, -jnp.inf)
        p = jax.nn.softmax(jnp.concatenate([s_sel, s_own], axis=-1), axis=-1).astype(qn.dtype)
        p_sel = p[..., :K * L].reshape(H, QC, K, L)
        p_own = p[..., K * L:]
        return (jnp.einsum('hqkl,hqkld->hqd', p_sel, v_sel)
                + jnp.einsum('hql,hld->hqd', p_own, v_own))

    out = lax.map(attend, (to_qchunks(q), to_qchunks(sel), to_qchunks(valid), b_idx, c_idx))
    out = jnp.swapaxes(out.reshape(B, NQ, H, QC, d), 1, 2)
    return out.reshape(B, H, S, d)


def hgrn2_recurrence(q, k, v, log_f):
    B, H, S, dk = q.shape
    dv = v.shape[-1]
    C = HGRN_CHUNK
    NC = S // C

    def to_chunks(t):
        return jnp.moveaxis(t.reshape(B, H, NC, C, t.shape[-1]), 2, 0)

    causal = jnp.tril(jnp.ones((C, C), dtype=bool))[:, :, None]

    def step(state, xs):
        qn, kn, vn, gn = xs
        b = jnp.cumsum(gn, axis=2)
        expo = jnp.where(causal, b[:, :, :, None, :] - b[:, :, None, :, :], -jnp.inf)
        attn = jnp.einsum('bhid,bhjd,bhijd->bhij', qn, kn, jnp.exp(expo))
        intra = jnp.einsum('bhij,bhje->bhie', attn, vn)
        cross = jnp.einsum('bhid,bhde->bhie', qn * jnp.exp(b), state)
        b_last = b[:, :, -1:, :]
        k_dec = kn * jnp.exp(b_last - b)
        new_state = (jnp.exp(b_last[:, :, 0, :])[..., None] * state
                     + jnp.einsum('bhjd,bhje->bhde', k_dec, vn))
        return new_state, intra + cross

    init = jnp.zeros((B, H, dk, dv), jnp.float32)
    _, out = lax.scan(step, init, (to_chunks(q), to_chunks(k), to_chunks(v), to_chunks(log_f)))
    return jnp.moveaxis(out, 0, 2).reshape(B, H, S, dv)


def hybrid_layer(x, lower_bound, norm_mix, w_in, ret_norm, hgrn_norm, w_branch_ret, w_branch_moba,
                 w_branch_hgrn, w_out, norm_ffn, w_ffn_gate, w_ffn_up, w_ffn_down):
    B, S, _ = x.shape
    dt = x.dtype
    f32 = jnp.float32
    pos = jnp.arange(S)
    h = rmsnorm(x, norm_mix)
    proj = h @ w_in
    (rq, rk, rv, rg, mq, mk, mv, hq, hf, hi, hg,
     gate_ret, gate_moba, gate_hgrn) = jnp.split(proj, IN_SPLITS, axis=-1)

    rq_h = rotary(split_heads(rq, RET_HEADS), pos, RET_HEAD_DIM, RET_ROPE_BASE).astype(f32)
    rk_h = rotary(split_heads(rk, RET_HEADS), pos, RET_HEAD_DIM, RET_ROPE_BASE).astype(f32)
    ret = retention(rq_h, rk_h, split_heads(rv, RET_HEADS).astype(f32))
    ret = merge_heads(head_layer_norm(ret)) * ret_norm.astype(f32)
    ret = ret.astype(dt) * jax.nn.silu(rg)

    mq_h = rotary(split_heads(mq, MOBA_HEADS), pos, ROPE_DIM, ROPE_THETA)
    mk_h = rotary(split_heads(mk, MOBA_HEADS), pos, ROPE_DIM, ROPE_THETA)
    moba = merge_heads(moba_attention(mq_h, mk_h, split_heads(mv, MOBA_HEADS)))

    f = lower_bound + (1.0 - lower_bound) * jax.nn.sigmoid(hf.astype(f32))
    hgrn = hgrn2_recurrence(split_heads(jax.nn.silu(hq.astype(f32)), HGRN_HEADS),
                            split_heads(1.0 - f, HGRN_HEADS),
                            split_heads(hi.astype(f32), HGRN_HEADS),
                            split_heads(jnp.log(f), HGRN_HEADS))
    hgrn = merge_heads(head_rms_norm(hgrn)) * hgrn_norm.astype(f32)
    hgrn = hgrn.astype(dt) * jax.nn.silu(hg)

    mixed = (jax.nn.sigmoid(gate_ret) * (ret @ w_branch_ret)
             + jax.nn.sigmoid(gate_moba) * (moba @ w_branch_moba)
             + jax.nn.sigmoid(gate_hgrn) * (hgrn @ w_branch_hgrn))
    x = x + mixed @ w_out

    h = rmsnorm(x, norm_ffn)
    x = x + (jax.nn.silu(h @ w_ffn_gate) * (h @ w_ffn_up)) @ w_ffn_down
    return x


def setup_inputs(seed: int = 0) -> dict:
    key = jax.random.key(seed)
    ks = jax.random.split(key, 16)
    f32 = jnp.float32

    def nrm(k, shape, fan_in):
        return jax.random.normal(k, shape, f32) * (fan_in ** -0.5)

    def gain(k, shape):
        return 1.0 + 0.02 * jax.random.normal(k, shape, f32)

    return {
        "x": jax.random.normal(ks[0], (BATCH, SEQ, D_MODEL), f32),
        "hgrn_lower_bounds": 0.5 * jax.random.normal(ks[1], (DEPTH, HGRN_WIDTH), f32),
        "norm_mix": gain(ks[2], (DEPTH, D_MODEL)),
        "w_in": nrm(ks[3], (DEPTH, D_MODEL, IN_COLS), D_MODEL),
        "ret_norm": gain(ks[4], (DEPTH, RET_WIDTH)),
        "hgrn_norm": gain(ks[5], (DEPTH, HGRN_WIDTH)),
        "w_branch_ret": nrm(ks[6], (DEPTH, RET_WIDTH, D_MODEL), RET_WIDTH),
        "w_branch_moba": nrm(ks[7], (DEPTH, MOBA_WIDTH, D_MODEL), MOBA_WIDTH),
        "w_branch_hgrn": nrm(ks[8], (DEPTH, HGRN_WIDTH, D_MODEL), HGRN_WIDTH),
        "w_out": nrm(ks[9], (DEPTH, D_MODEL, D_MODEL), D_MODEL),
        "norm_ffn": gain(ks[10], (DEPTH, D_MODEL)),
        "w_ffn_gate": nrm(ks[11], (DEPTH, D_MODEL, FFN_HIDDEN), D_MODEL),
        "w_ffn_up": nrm(ks[12], (DEPTH, D_MODEL, FFN_HIDDEN), D_MODEL),
        "w_ffn_down": nrm(ks[13], (DEPTH, FFN_HIDDEN, D_MODEL), FFN_HIDDEN),
        "final_norm": gain(ks[14], (D_MODEL,)),
    }


def reference(x, hgrn_lower_bounds, norm_mix, w_in, ret_norm, hgrn_norm, w_branch_ret, w_branch_moba,
              w_branch_hgrn, w_out, norm_ffn, w_ffn_gate, w_ffn_up, w_ffn_down, final_norm):
    lb_soft = jax.nn.softmax(hgrn_lower_bounds.astype(jnp.float32), axis=0)
    lower_bounds = jnp.cumsum(lb_soft, axis=0) - lb_soft[0]
    h = x
    for layer in range(DEPTH):
        h = hybrid_layer(h, lower_bounds[layer], norm_mix[layer], w_in[layer], ret_norm[layer],
                         hgrn_norm[layer], w_branch_ret[layer], w_branch_moba[layer], w_branch_hgrn[layer],
                         w_out[layer], norm_ffn[layer], w_ffn_gate[layer], w_ffn_up[layer], w_ffn_down[layer])
    return rmsnorm(h, final_norm)
```

```cpp
#include <hip/hip_runtime.h>
#include <hip/hip_cooperative_groups.h>
#include <cstdio>
namespace cg = cooperative_groups;

#define LAS __attribute__((address_space(3)))
typedef unsigned short bf16_t;
typedef short bf16x8 __attribute__((ext_vector_type(8)));
typedef short bf16x4 __attribute__((ext_vector_type(4)));
typedef float f32x4 __attribute__((ext_vector_type(4)));
typedef unsigned u32x4 __attribute__((ext_vector_type(4)));
typedef unsigned u32x2 __attribute__((ext_vector_type(2)));

constexpr int DM = 2048, SEQ = 4096, NTOK = 16384, DEPTH = 2;
constexpr int INC = 17408, PA = 11264, GC = 6144, FH = 5632;
constexpr int C_RQ = 0, C_RK = 1024, C_RV = 2048, C_RG = 3072, C_MQ = 4096, C_MK = 5120, C_MV = 6144, C_HQ = 7168, C_HF = 8192, C_HI = 9216, C_HG = 10240;
constexpr float EPS = 1e-6f;

constexpr size_t E_WIN = (size_t)DM * INC, E_WBR = (size_t)1024 * DM, E_WOUT = (size_t)DM * DM, E_WGU = (size_t)2 * DM * FH, E_WDN = (size_t)FH * DM;
constexpr size_t WS_WIN = 0;
constexpr size_t WS_WBR = WS_WIN + E_WIN * 2;
constexpr size_t WS_WOUT = WS_WBR + 3 * E_WBR * 2;
constexpr size_t WS_WGU = WS_WOUT + E_WOUT * 2;
constexpr size_t WS_WDN = WS_WGU + E_WGU * 2;
constexpr size_t WS_HB = WS_WDN + E_WDN * 2;
constexpr size_t WS_PROJA = WS_HB + (size_t)NTOK * DM * 2;
constexpr size_t WS_MIXB = WS_PROJA;
constexpr size_t WS_MIX32 = WS_PROJA + (size_t)NTOK * DM * 2;
constexpr size_t WS_FFH = WS_MIX32;
constexpr size_t WS_GATES = WS_PROJA + (size_t)NTOK * PA * 2;
constexpr size_t WS_BOUT = WS_GATES + (size_t)NTOK * GC * 2;
constexpr size_t WS_STR = WS_BOUT + (size_t)3 * NTOK * 1024 * 2;
constexpr size_t WS_STH = WS_STR + (size_t)512 * 65536 * 2;
constexpr size_t WS_HDEC = WS_STH + (size_t)2048 * 16384 * 2;
constexpr size_t WS_KMEAN = WS_HDEC + (size_t)2048 * 128 * 4;
constexpr size_t WS_ROPER = WS_KMEAN + (size_t)512 * 128 * 4;
constexpr size_t WS_ROPEM = WS_ROPER + (size_t)2 * 4096 * 128 * 4;
constexpr size_t WS_CTR = WS_ROPEM + (size_t)2 * 4096 * 16 * 4;
constexpr size_t WS_XBAR = WS_CTR + 256;
constexpr size_t WS_END = WS_XBAR + 3456 * 4;

constexpr int LDS_BYTES = 160 * 1024;
constexpr int LDS_ITEM_OFF = LDS_BYTES - 16;

struct Params {
    const float* x; const float* lb; const float* norm_mix; const float* w_in; const float* ret_norm; const float* hgrn_norm;
    const float* w_br[3]; const float* w_out; const float* norm_ffn; const float* w_gate; const float* w_up; const float* w_down; const float* final_norm;
    float* out; unsigned char* ws;
};

typedef __bf16 bf16v2_t __attribute__((ext_vector_type(2)));
typedef float f32x2_t __attribute__((ext_vector_type(2)));
__device__ __forceinline__ unsigned cvt_pk_bf16(float lo, float hi) { const f32x2_t v = {lo, hi}; const bf16v2_t b = __builtin_convertvector(v, bf16v2_t); return __builtin_bit_cast(unsigned, b); }
__device__ __forceinline__ float bf2f(unsigned short b) { return __uint_as_float(((unsigned)b) << 16); }
__device__ __forceinline__ float bflo(unsigned w) { return __uint_as_float(w << 16); }
__device__ __forceinline__ float bfhi(unsigned w) { return __uint_as_float(w & 0xffff0000u); }
__device__ __forceinline__ float frcp_(float x) { return __builtin_amdgcn_rcpf(x); }
__device__ __forceinline__ float sigmoidf_(float v) { return frcp_(1.f + __expf(-v)); }
__device__ __forceinline__ float siluf_(float v) { return v * frcp_(1.f + __expf(-v)); }
__device__ __forceinline__ int tid_fresh() { int t = threadIdx.x; asm volatile("" : "+v"(t)); return t; }
__device__ __forceinline__ float wave_sum(float v) {
#pragma unroll
    for (int o = 1; o < 64; o <<= 1) v += __shfl_xor(v, o);
    return v;
}

namespace pg8 {
constexpr int BM = 256, BK = 64, HALF = 128, HTB = HALF * BK * 2, STAGE_BYTES = 8 * HTB, NXCD = 8, WGM = 8;
__host__ __device__ __forceinline__ int lds_byte(int r, int c) { const int st = (r >> 4) * 2 + (c >> 5), rr = r & 15, cc = c & 31, ob = rr * 64 + cc * 2; return st * 1024 + (ob ^ (((ob >> 9) & 1) << 5)); }
__host__ __device__ __forceinline__ void stage_rc(int b, int& R, int& C) { const int st = b / 1024, sb = b % 1024, swz = sb ^ (((sb >> 9) & 1) << 5); R = (st >> 1) * 16 + swz / 64; C = (st & 1) * 32 + (swz % 64) / 2; }
__host__ __device__ __forceinline__ int perm32(int rho) { const int n = rho >> 4, i = rho & 15; return 8 * (i >> 2) + 4 * n + (i & 3); }

struct Unit { int pm, pn, z; };
struct Sched {
    int nM, nN, nwg, G, c, nz, K;
    const bf16_t* A0; const bf16_t* B0; size_t zsA, zsB;
    __device__ void init(int M, int N, int K_, int G_, int c_, int nz_) { nM = M / BM; nN = N / BM; nwg = nM * nN; G = G_; c = c_; nz = nz_; K = K_; }
    __device__ bool next(int i, Unit& u) const {
        const int r = i / nz; u.z = i - r * nz;
        const long L = (long)r * G + c; if (L >= nwg) return false;
        int wgid = (int)L; { const int q = nwg / NXCD, rr = nwg % NXCD, xcd = wgid % NXCD, off = wgid / NXCD; wgid = (xcd < rr ? xcd * (q + 1) : rr * (q + 1) + (xcd - rr) * q) + off; }
        const int nig = WGM * nN, gid = wgid / nig, fm = gid * WGM, gsz = (nM - fm) < WGM ? (nM - fm) : WGM;
        u.pm = fm + ((wgid % nig) % gsz); u.pn = (wgid % nig) / gsz; return true;
    }
    __device__ __forceinline__ const char* baseA(const Unit& u) const { return (const char*)(A0 + (size_t)u.z * zsA) + (size_t)u.pm * (size_t)BM * K * 2; }
    __device__ __forceinline__ const char* baseB(const Unit& u) const { return (const char*)(B0 + (size_t)u.z * zsB) + (size_t)u.pn * (size_t)BM * K * 2; }
};

template <class Epi>
__device__ __forceinline__ void gemm_phase(LAS unsigned char* lds, const Sched& S, const Epi& E) {
    const int tid = tid_fresh(), wid = __builtin_amdgcn_readfirstlane(tid >> 6), lane = tid & 63, wr = wid >> 2, wc = wid & 3, fr = lane & 15, fq = lane >> 4;
    const int K = S.K, nt = K / BK;
    unsigned voffA[2], voffB[2];
#pragma unroll
    for (int i = 0; i < 2; ++i) { int R, C; stage_rc(tid * 16 + i * 8192, R, C); const int Rb = Epi::PERM ? ((R & ~31) + perm32(R & 31)) : R;
        voffA[i] = (unsigned)(R * K + C) * 2u; voffB[i] = (unsigned)(Rb * K + C) * 2u; }
    const size_t kstep = (size_t)(BK * 2);
    const size_t hstep = (size_t)HALF * K * 2;
    const unsigned ldsw = (unsigned)wid * 1024u;
    const int aoff = lds_byte(wr * 64 + fr, fq * 8), boff = lds_byte(wc * 32 + fr, fq * 8);
#define PG8_SA(b, h) (((b) * 2 + (h)) * HTB)
#define PG8_SB(b, h) ((4 + (b) * 2 + (h)) * HTB)
#define PG8_STAGE(bufoff, gbase, voff) do { _Pragma("unroll") for (int _i = 0; _i < 2; ++_i) \
        __builtin_amdgcn_global_load_lds((const unsigned*)((const char*)(gbase) + (voff)[_i]), (LAS unsigned*)(lds + (bufoff) + ldsw + _i * 8192), 16, 0, 0); } while (0)
#define PG8_LDA(dst, b, h) do { _Pragma("unroll") for (int m = 0; m < 4; ++m) _Pragma("unroll") for (int k = 0; k < 2; ++k) dst[m][k] = *(const LAS bf16x8*)(lds + PG8_SA(b, h) + aoff + m * 2048 + k * 1024); } while (0)
#define PG8_LDB(dst, b, h) do { _Pragma("unroll") for (int n = 0; n < 2; ++n) _Pragma("unroll") for (int k = 0; k < 2; ++k) dst[n][k] = *(const LAS bf16x8*)(lds + PG8_SB(b, h) + boff + n * 2048 + k * 1024); } while (0)
#define PG8_MMA(ai, bj, At, Bt) do { __builtin_amdgcn_s_setprio(1); _Pragma("unroll") for (int m = 0; m < 4; ++m) _Pragma("unroll") for (int n = 0; n < 2; ++n) _Pragma("unroll") for (int k = 0; k < 2; ++k) \
        acc[ai][bj][m][n] = __builtin_amdgcn_mfma_f32_16x16x32_bf16(Bt[n][k], At[m][k], acc[ai][bj][m][n], 0, 0, 0); __builtin_amdgcn_s_setprio(0); } while (0)
#define PG8_WAIT_V(n) asm volatile("s_waitcnt vmcnt(" #n ")" ::: "memory")
#define PG8_WAIT_L(n) asm volatile("s_waitcnt lgkmcnt(" #n ")" ::: "memory")
#define PG8_BAR __builtin_amdgcn_s_barrier()
#define PG8_SCHED __builtin_amdgcn_sched_barrier(0)
    Unit cur, nxt; int ui = 0;
    if (!S.next(0, cur)) return;
    f32x4 acc[2][2][4][2];
#pragma unroll
    for (int a = 0; a < 2; ++a)
#pragma unroll
        for (int b = 0; b < 2; ++b)
#pragma unroll
            for (int m = 0; m < 4; ++m)
#pragma unroll
                for (int n = 0; n < 2; ++n) acc[a][b][m][n] = (f32x4){0.f, 0.f, 0.f, 0.f};
    bf16x8 At[4][2], B0[2][2], B1[2][2];
    const char* cA = S.baseA(cur); const char* cB = S.baseB(cur);
    PG8_STAGE(PG8_SB(0, 0), cB, voffB); PG8_STAGE(PG8_SB(0, 1), cB + hstep, voffB); PG8_STAGE(PG8_SA(0, 0), cA, voffA); PG8_STAGE(PG8_SA(0, 1), cA + hstep, voffA);
    if (wr == 1) PG8_BAR;
    PG8_WAIT_V(2); PG8_BAR;
    PG8_STAGE(PG8_SB(1, 0), cB + kstep, voffB); PG8_STAGE(PG8_SA(1, 0), cA + kstep, voffA); PG8_STAGE(PG8_SB(1, 1), cB + hstep + kstep, voffB);
    PG8_WAIT_V(6); PG8_BAR;
    for (;;) {
        const bool has_next = S.next(ui + 1, nxt);
        const char* nA = has_next ? S.baseA(nxt) : cA; const char* nB = has_next ? S.baseB(nxt) : cB;
        for (int t = 0; t < nt; t += 2) {
            const bool last = (t == nt - 2);
            const char* a1 = cA + (size_t)(t + 1) * kstep;
            const char* a2 = last ? nA : cA + (size_t)(t + 2) * kstep; const char* b2 = last ? nB : cB + (size_t)(t + 2) * kstep;
            const char* a3 = a2 + kstep; const char* b3 = b2 + kstep;
            PG8_LDB(B0, 0, 0); PG8_LDB(B1, 0, 1); PG8_SCHED; PG8_LDA(At, 0, 0); PG8_STAGE(PG8_SA(1, 1), a1 + hstep, voffA);
            PG8_WAIT_V(8); PG8_WAIT_L(0); PG8_BAR; PG8_MMA(0, 0, At, B0); PG8_MMA(0, 1, At, B1); PG8_BAR; PG8_SCHED;
            PG8_LDA(At, 0, 1); PG8_STAGE(PG8_SB(0, 0), b2, voffB); PG8_STAGE(PG8_SB(0, 1), b2 + hstep, voffB); PG8_STAGE(PG8_SA(0, 0), a2, voffA);
            PG8_WAIT_V(8); PG8_WAIT_L(0); PG8_BAR; PG8_MMA(1, 0, At, B0); PG8_MMA(1, 1, At, B1); PG8_BAR; PG8_SCHED;
            PG8_LDB(B0, 1, 0); PG8_LDB(B1, 1, 1); PG8_SCHED; PG8_LDA(At, 1, 0); PG8_STAGE(PG8_SA(0, 1), a2 + hstep, voffA);
            PG8_WAIT_V(8); PG8_WAIT_L(0); PG8_BAR; PG8_MMA(0, 0, At, B0); PG8_MMA(0, 1, At, B1); PG8_BAR; PG8_SCHED;
            PG8_LDA(At, 1, 1); PG8_STAGE(PG8_SB(1, 0), b3, voffB); PG8_STAGE(PG8_SB(1, 1), b3 + hstep, voffB); PG8_STAGE(PG8_SA(1, 0), a3, voffA);
            PG8_WAIT_V(8); PG8_WAIT_L(0); PG8_BAR; PG8_MMA(1, 0, At, B0); PG8_MMA(1, 1, At, B1); PG8_BAR; PG8_SCHED;
        }
        if (wr == 0) PG8_BAR;
        bool keep = false;
        if constexpr (Epi::ZACC) { if (cur.z + 1 < S.nz) { E.mid(acc, cur, wr, wc, fr, fq); keep = true; } }
        if (!keep) E(acc, cur, wr, wc, fr, fq);
        if (!has_next) break;
        if (!keep)
        {
#pragma unroll
        for (int a = 0; a < 2; ++a)
#pragma unroll
            for (int b = 0; b < 2; ++b)
#pragma unroll
                for (int m = 0; m < 4; ++m)
#pragma unroll
                    for (int n = 0; n < 2; ++n) acc[a][b][m][n] = (f32x4){0.f, 0.f, 0.f, 0.f};
        }
        cur = nxt; cA = nA; cB = nB; ++ui;
        if (wr == 1) PG8_BAR;
    }
    PG8_WAIT_V(0);
    PG8_BAR;
#undef PG8_SA
#undef PG8_SB
#undef PG8_STAGE
#undef PG8_LDA
#undef PG8_LDB
#undef PG8_MMA
#undef PG8_WAIT_V
#undef PG8_WAIT_L
#undef PG8_BAR
#undef PG8_SCHED
}
}
using pg8::Unit;
typedef f32x4 AccT[2][2][4][2];

struct EpiIn {
    static constexpr bool PERM = true; static constexpr bool ZACC = false;
    bf16_t* projA; bf16_t* gates; const float* ropeR; const float* ropeM;
    __device__ __forceinline__ void operator()(AccT& acc, const Unit& u, int wr, int wc, int fr, int fq) const {
        const int pn = u.pn;
        const int row0 = u.pm * 256 + wr * 64 + fr;
        bf16_t* base; int ld, colt;
        if (pn < 44) { base = projA; ld = PA; colt = pn * 256; } else { base = gates; ld = GC; colt = (pn - 44) * 256; }
        const int col0 = colt + wc * 32 + 8 * fq;
        const int kind = pn < 8 ? 1 : ((pn >= 16 && pn < 24 && wc == 0) ? 2 : 0);
        const float* rt = kind == 1 ? ropeR : ropeM; const int rld = kind == 1 ? 128 : 16;
        const int i0 = kind == 1 ? wc * 32 + 8 * fq : 8 * (fq & 1);
        const float sc = (kind == 1 && pn >= 4) ? 0.0625f : 1.f;
        f32x4 cc[2], ss[2], cn[2], sn[2];
#pragma unroll
        for (int n = 0; n < 2; ++n) { cc[n] = ss[n] = cn[n] = sn[n] = (f32x4){0.f, 0.f, 0.f, 0.f}; }
        if (kind) { const int pos = row0 & (SEQ - 1);
#pragma unroll
            for (int n = 0; n < 2; ++n) { cc[n] = *(const f32x4*)(rt + (size_t)pos * rld + i0 + 4 * n); ss[n] = *(const f32x4*)(rt + (size_t)(SEQ + pos) * rld + i0 + 4 * n); } }
#pragma unroll
        for (int g = 0; g < 8; ++g) {
            const int ai = g >> 2, m = g & 3, row = row0 + ai * 128 + m * 16;
            if (kind && g < 7) { const int pos2 = (row0 + ((g + 1) >> 2) * 128 + ((g + 1) & 3) * 16) & (SEQ - 1);
#pragma unroll
                for (int n = 0; n < 2; ++n) { cn[n] = *(const f32x4*)(rt + (size_t)pos2 * rld + i0 + 4 * n); sn[n] = *(const f32x4*)(rt + (size_t)(SEQ + pos2) * rld + i0 + 4 * n); } }
            f32x4 v[2][2];
#pragma unroll
            for (int bj = 0; bj < 2; ++bj)
#pragma unroll
                for (int n = 0; n < 2; ++n) v[bj][n] = acc[ai][bj][m][n];
            if (kind == 1) {
#pragma unroll
                for (int n = 0; n < 2; ++n) { const f32x4 x1 = v[0][n], x2 = v[1][n];
                    v[0][n] = (x1 * cc[n] - x2 * ss[n]) * sc; v[1][n] = (x2 * cc[n] + x1 * ss[n]) * sc; }
            } else if (kind == 2) {
#pragma unroll
                for (int n = 0; n < 2; ++n) { const f32x4 sg = fq < 2 ? -ss[n] : ss[n];
#pragma unroll
                    for (int bj = 0; bj < 2; ++bj) { f32x4 p;
#pragma unroll
                        for (int j = 0; j < 4; ++j) p[j] = __shfl_xor(v[bj][n][j], 32);
                        v[bj][n] = v[bj][n] * cc[n] + p * sg; } }
            }
            bf16_t* rowp = base + (size_t)row * ld + col0;
#pragma unroll
            for (int bj = 0; bj < 2; ++bj) {
                u32x4 w; w.x = cvt_pk_bf16(v[bj][0][0], v[bj][0][1]); w.y = cvt_pk_bf16(v[bj][0][2], v[bj][0][3]); w.z = cvt_pk_bf16(v[bj][1][0], v[bj][1][1]); w.w = cvt_pk_bf16(v[bj][1][2], v[bj][1][3]);
                *(u32x4*)(rowp + bj * 128) = w;
            }
#pragma unroll
            for (int n = 0; n < 2; ++n) { cc[n] = cn[n]; ss[n] = sn[n]; }
        }
    }
};
struct EpiBr {
    static constexpr bool PERM = false; static constexpr bool ZACC = true;
    const bf16_t* gates; bf16_t* mixb;
    __device__ __forceinline__ void mid(AccT& acc, const Unit& u, int wr, int wc, int fr, int fq) const {
        const int row0 = u.pm * 256 + wr * 64 + fr, col0 = u.pn * 256 + wc * 32 + 4 * fq, z = u.z;
        u32x2 ac[2][2], bc[2][2], an[2][2], bn[2][2];
#pragma unroll
        for (int bj = 0; bj < 2; ++bj)
#pragma unroll
            for (int n = 0; n < 2; ++n) { const bf16_t* gp = gates + (size_t)row0 * GC + z * DM + col0 + bj * 128 + n * 16; ac[bj][n] = *(const u32x2*)gp; bc[bj][n] = *(const u32x2*)(gp + DM); }
#pragma unroll
        for (int g = 0; g < 8; ++g) {
            const int ai = g >> 2, m = g & 3;
            if (g < 7) { const int row2 = row0 + ((g + 1) >> 2) * 128 + ((g + 1) & 3) * 16;
#pragma unroll
                for (int bj = 0; bj < 2; ++bj)
#pragma unroll
                    for (int n = 0; n < 2; ++n) { const bf16_t* gp = gates + (size_t)row2 * GC + z * DM + col0 + bj * 128 + n * 16; an[bj][n] = *(const u32x2*)gp; bn[bj][n] = *(const u32x2*)(gp + DM); } }
#pragma unroll
            for (int bj = 0; bj < 2; ++bj)
#pragma unroll
                for (int n = 0; n < 2; ++n) {
                    const u32x2 ga = ac[bj][n], gb = bc[bj][n];
                    f32x4 v = acc[ai][bj][m][n];
                    v[0] *= (1.f + __expf(fminf(-bflo(gb.x), 80.f))) * frcp_(1.f + __expf(fminf(-bflo(ga.x), 80.f)));
                    v[1] *= (1.f + __expf(fminf(-bfhi(gb.x), 80.f))) * frcp_(1.f + __expf(fminf(-bfhi(ga.x), 80.f)));
                    v[2] *= (1.f + __expf(fminf(-bflo(gb.y), 80.f))) * frcp_(1.f + __expf(fminf(-bflo(ga.y), 80.f)));
                    v[3] *= (1.f + __expf(fminf(-bfhi(gb.y), 80.f))) * frcp_(1.f + __expf(fminf(-bfhi(ga.y), 80.f)));
                    acc[ai][bj][m][n] = v;
                }
#pragma unroll
            for (int bj = 0; bj < 2; ++bj)
#pragma unroll
                for (int n = 0; n < 2; ++n) { ac[bj][n] = an[bj][n]; bc[bj][n] = bn[bj][n]; }
        }
    }
    __device__ __forceinline__ void operator()(AccT& acc, const Unit& u, int wr, int wc, int fr, int fq) const {
        const int row0 = u.pm * 256 + wr * 64 + fr, col0 = u.pn * 256 + wc * 32 + 4 * fq, z = u.z;
        u32x2 gc[2][2], gn[2][2];
#pragma unroll
        for (int bj = 0; bj < 2; ++bj)
#pragma unroll
            for (int n = 0; n < 2; ++n) gc[bj][n] = *(const u32x2*)(gates + (size_t)row0 * GC + z * DM + col0 + bj * 128 + n * 16);
#pragma unroll
        for (int g = 0; g < 8; ++g) {
            const int ai = g >> 2, m = g & 3, row = row0 + ai * 128 + m * 16;
            if (g < 7) { const int row2 = row0 + ((g + 1) >> 2) * 128 + ((g + 1) & 3) * 16;
#pragma unroll
                for (int bj = 0; bj < 2; ++bj)
#pragma unroll
                    for (int n = 0; n < 2; ++n) gn[bj][n] = *(const u32x2*)(gates + (size_t)row2 * GC + z * DM + col0 + bj * 128 + n * 16); }
#pragma unroll
            for (int bj = 0; bj < 2; ++bj)
#pragma unroll
                for (int n = 0; n < 2; ++n) {
                    const int col = col0 + bj * 128 + n * 16;
                    const u32x2 gg = gc[bj][n];
                    const f32x4 v = acc[ai][bj][m][n];
                    u32x2 w; w.x = cvt_pk_bf16(v[0] * sigmoidf_(bflo(gg.x)), v[1] * sigmoidf_(bfhi(gg.x))); w.y = cvt_pk_bf16(v[2] * sigmoidf_(bflo(gg.y)), v[3] * sigmoidf_(bfhi(gg.y)));
                    *(u32x2*)(mixb + (size_t)row * DM + col) = w;
                }
#pragma unroll
            for (int bj = 0; bj < 2; ++bj)
#pragma unroll
                for (int n = 0; n < 2; ++n) gc[bj][n] = gn[bj][n];
        }
    }
};
struct EpiRes {
    static constexpr bool PERM = false; static constexpr bool ZACC = false;
    const float* xin; float* xout;
    __device__ __forceinline__ void operator()(AccT& acc, const Unit& u, int wr, int wc, int fr, int fq) const {
        const int row0 = u.pm * 256 + wr * 64 + fr, col0 = u.pn * 256 + wc * 32 + 4 * fq;
        f32x4 cur[2][2], nxt[2][2];
        { const size_t ro = (size_t)row0 * DM + col0;
#pragma unroll
          for (int bj = 0; bj < 2; ++bj)
#pragma unroll
              for (int n = 0; n < 2; ++n) cur[bj][n] = *(const f32x4*)(xin + ro + bj * 128 + n * 16); }
#pragma unroll
        for (int g = 0; g < 8; ++g) {
            const int ai = g >> 2, m = g & 3;
            if (g < 7) { const int ai2 = (g + 1) >> 2, m2 = (g + 1) & 3; const size_t ro2 = (size_t)(row0 + ai2 * 128 + m2 * 16) * DM + col0;
#pragma unroll
                for (int bj = 0; bj < 2; ++bj)
#pragma unroll
                    for (int n = 0; n < 2; ++n) nxt[bj][n] = *(const f32x4*)(xin + ro2 + bj * 128 + n * 16); }
            const size_t ro = (size_t)(row0 + ai * 128 + m * 16) * DM + col0;
#pragma unroll
            for (int bj = 0; bj < 2; ++bj)
#pragma unroll
                for (int n = 0; n < 2; ++n) *(f32x4*)(xout + ro + bj * 128 + n * 16) = acc[ai][bj][m][n] + cur[bj][n];
#pragma unroll
            for (int bj = 0; bj < 2; ++bj)
#pragma unroll
                for (int n = 0; n < 2; ++n) cur[bj][n] = nxt[bj][n];
        }
    }
};
struct EpiGU {
    static constexpr bool PERM = true; static constexpr bool ZACC = false;
    bf16_t* ffh;
    __device__ __forceinline__ void operator()(AccT& acc, const Unit& u, int wr, int wc, int fr, int fq) const {
        const int row0 = u.pm * 256 + wr * 64 + fr, col0 = u.pn * 128 + wc * 32 + 8 * fq;
#pragma unroll
        for (int ai = 0; ai < 2; ++ai)
#pragma unroll
            for (int m = 0; m < 4; ++m) {
                f32x4 h0 = acc[ai][0][m][0], h1 = acc[ai][0][m][1]; const f32x4 u0 = acc[ai][1][m][0], u1 = acc[ai][1][m][1];
#pragma unroll
                for (int j = 0; j < 4; ++j) { h0[j] = siluf_(h0[j]) * u0[j]; h1[j] = siluf_(h1[j]) * u1[j]; }
                u32x4 w; w.x = cvt_pk_bf16(h0[0], h0[1]); w.y = cvt_pk_bf16(h0[2], h0[3]); w.z = cvt_pk_bf16(h1[0], h1[1]); w.w = cvt_pk_bf16(h1[2], h1[3]);
                *(u32x4*)(ffh + (size_t)(row0 + ai * 128 + m * 16) * FH + col0) = w;
            }
    }
};

__device__ __forceinline__ void transpose_item(const float* W, int K, int N, bf16_t* WT, int grp_shift, int gmul, int goff, float* scr, int item, int lane) {
    const int nblk = N / 32, kb = item / nblk, nb = item - kb * nblk, k0 = 64 * kb, n0 = 32 * nb;
    float wv[32];
    { const float* wp = W + (size_t)(k0 + (lane >> 5)) * N + n0 + (lane & 31);
#pragma unroll
      for (int i = 0; i < 32; ++i) wv[i] = __builtin_nontemporal_load(wp + (size_t)(2 * i) * N); }
#pragma unroll
    for (int i = 0; i < 32; ++i) scr[(2 * i + (lane >> 5)) * 33 + (lane & 31)] = wv[i];
    __builtin_amdgcn_wave_barrier();
    const int c = lane & 7;
#pragma unroll
    for (int j = 0; j < 4; ++j) { const int n = (lane >> 3) + 8 * j; const float* s = scr + (8 * c) * 33 + n;
        u32x4 o; o.x = cvt_pk_bf16(s[0 * 33], s[1 * 33]); o.y = cvt_pk_bf16(s[2 * 33], s[3 * 33]); o.z = cvt_pk_bf16(s[4 * 33], s[5 * 33]); o.w = cvt_pk_bf16(s[6 * 33], s[7 * 33]);
        const int ng = n0 + n; const int drow = grp_shift >= 0 ? (((ng >> grp_shift) * gmul) + goff + (ng & ((1 << grp_shift) - 1))) : ng;
        *(u32x4*)(WT + (size_t)drow * K + k0 + 8 * c) = o; }
    __builtin_amdgcn_wave_barrier();
}

__device__ __forceinline__ void rmsnorm_rows_bf16(const float* x, const float* g, bf16_t* o, int gw, int ngw, int lane) {
    for (int r = gw; r < NTOK; r += 2 * ngw) {
        const int r2 = r + ngw;
        const f32x4* xa = (const f32x4*)(x + (size_t)r * DM) + lane; const f32x4* xb = (const f32x4*)(x + (size_t)r2 * DM) + lane;
        f32x4 va[8], vb[8]; float sa = 0.f, sb = 0.f;
#pragma unroll
        for (int j = 0; j < 8; ++j) { va[j] = xa[64 * j]; vb[j] = xb[64 * j]; }
#pragma unroll
        for (int j = 0; j < 8; ++j) { sa += (va[j].x * va[j].x + va[j].y * va[j].y) + (va[j].z * va[j].z + va[j].w * va[j].w); sb += (vb[j].x * vb[j].x + vb[j].y * vb[j].y) + (vb[j].z * vb[j].z + vb[j].w * vb[j].w); }
#pragma unroll
        for (int o2 = 1; o2 < 64; o2 <<= 1) { sa += __shfl_xor(sa, o2); sb += __shfl_xor(sb, o2); }
        const float ra = 1.f / sqrtf(sa * (1.f / DM) + EPS), rb = 1.f / sqrtf(sb * (1.f / DM) + EPS);
        u32x2* oa = (u32x2*)(o + (size_t)r * DM) + lane; u32x2* ob = (u32x2*)(o + (size_t)r2 * DM) + lane;
#pragma unroll
        for (int j = 0; j < 8; ++j) { const f32x4 gg = *((const f32x4*)g + lane + 64 * j);
            u32x2 w; w.x = cvt_pk_bf16(va[j].x * ra * gg.x, va[j].y * ra * gg.y); w.y = cvt_pk_bf16(va[j].z * ra * gg.z, va[j].w * ra * gg.w); oa[64 * j] = w;
            u32x2 w2; w2.x = cvt_pk_bf16(vb[j].x * rb * gg.x, vb[j].y * rb * gg.y); w2.y = cvt_pk_bf16(vb[j].z * rb * gg.z, vb[j].w * rb * gg.w); ob[64 * j] = w2; }
    }
}

__device__ __forceinline__ void rope_entry(double base_log2, int rot, int i, int pos, float& co, float& si) {
    const double inv = exp2(-(2.0 * i / rot) * base_log2);
    const double ang = (double)pos * inv;
    const double TWO_PI = 6.283185307179586476925286766559;
    const double k = rint(ang / TWO_PI);
    const double r = fma(-k, 2.4492935982947064e-16, fma(-k, TWO_PI, ang));
    const double r2 = r * r;
    double ts = r, ss = r, tc = 1.0, sc = 1.0;
#pragma unroll
    for (int n = 1; n <= 14; ++n) { ts *= -r2 / (double)((2 * n) * (2 * n + 1)); ss += ts; tc *= -r2 / (double)((2 * n - 1) * (2 * n)); sc += tc; }
    co = (float)sc; si = (float)ss;
}

__device__ __forceinline__ void prep_phase(const Params& p, int layer, unsigned char* lds, const float* xin, const float* gain) {
    const int tid = tid_fresh(), wave = tid >> 6, lane = tid & 63;
    const int G = gridDim.x, gw = blockIdx.x * 8 + wave, ngw = G * 8;
    float* scr = (float*)(lds + wave * 16384);
    unsigned char* ws = p.ws;
    if (layer == 0) {
        if (blockIdx.x == 0) { if (tid < 64) ((unsigned*)(ws + WS_CTR))[tid] = 0u; for (int e = tid; e < 3456; e += 512) ((unsigned*)(ws + WS_XBAR))[e] = 0u; }
        float* rr = (float*)(ws + WS_ROPER); float* rm = (float*)(ws + WS_ROPEM);
        const int gt = blockIdx.x * 512 + tid, ngt = G * 512;
        for (int e = gt; e < SEQ * 128; e += ngt) { const int pos = e >> 7, i = e & 127; float c, s; rope_entry(13.287712379549449, 256, i, pos, c, s); rr[e] = c; rr[SEQ * 128 + e] = s; }
        for (int e = gt; e < SEQ * 16; e += ngt) { const int pos = e >> 4, i = e & 15; float c, s; rope_entry(18.931568569324174, 32, i, pos, c, s); rm[e] = c; rm[SEQ * 16 + e] = s; }
    }
    constexpr int I_IN = (DM / 64) * (INC / 32), I_BR = (1024 / 64) * (DM / 32), I_OUT = (DM / 64) * (DM / 32), I_G = (DM / 64) * (FH / 32), I_DN = (FH / 64) * (DM / 32);
    constexpr int NITEMS = I_IN + 3 * I_BR + I_OUT + 2 * I_G + I_DN;
    for (int it = gw; it < NITEMS; it += ngw) {
        int r = it;
        if (r < I_IN) { transpose_item(p.w_in + (size_t)layer * E_WIN, DM, INC, (bf16_t*)(ws + WS_WIN), -1, 0, 0, scr, r, lane); continue; } r -= I_IN;
        if (r < 3 * I_BR) { const int b = r / I_BR; transpose_item(p.w_br[b] + (size_t)layer * E_WBR, 1024, DM, (bf16_t*)(ws + WS_WBR) + (size_t)b * E_WBR, -1, 0, 0, scr, r - b * I_BR, lane); continue; } r -= 3 * I_BR;
        if (r < I_OUT) { transpose_item(p.w_out + (size_t)layer * E_WOUT, DM, DM, (bf16_t*)(ws + WS_WOUT), -1, 0, 0, scr, r, lane); continue; } r -= I_OUT;
        if (r < I_G) { transpose_item(p.w_gate + (size_t)layer * DM * FH, DM, FH, (bf16_t*)(ws + WS_WGU), 7, 256, 0, scr, r, lane); continue; } r -= I_G;
        if (r < I_G) { transpose_item(p.w_up + (size_t)layer * DM * FH, DM, FH, (bf16_t*)(ws + WS_WGU), 7, 256, 128, scr, r, lane); continue; } r -= I_G;
        transpose_item(p.w_down + (size_t)layer * E_WDN, FH, DM, (bf16_t*)(ws + WS_WDN), -1, 0, 0, scr, r, lane);
    }
    rmsnorm_rows_bf16(xin, gain, (bf16_t*)(ws + WS_HB), gw, ngw, lane);
}

template <bool SWAP>
__device__ __forceinline__ f32x4 mma_tile(const bf16_t* A, int lda, const bf16_t* B, int ldb, int ksteps, f32x4 acc, int lane) {
    const bf16_t* ap = A + (lane & 15) * lda + (lane >> 4) * 8;
    const bf16_t* bp = B + (lane & 15) * ldb + (lane >> 4) * 8;
    for (int ks = 0; ks < ksteps; ++ks) {
        const bf16x8 a = *(const bf16x8*)(ap + ks * 32), b = *(const bf16x8*)(bp + ks * 32);
        acc = SWAP ? __builtin_amdgcn_mfma_f32_16x16x32_bf16(b, a, acc, 0, 0, 0) : __builtin_amdgcn_mfma_f32_16x16x32_bf16(a, b, acc, 0, 0, 0);
    }
    return acc;
}
__device__ __forceinline__ void stage_copy(const bf16_t* src, int ld, int nrows, int ncols, bf16_t* dst, int lds_ld, int tid) {
    const int cgs = ncols >> 3, total = nrows * cgs;
    for (int idx = tid; idx < total; idx += 512) { const int r = idx / cgs, c = idx - r * cgs;
        *(u32x4*)(dst + r * lds_ld + c * 8) = *(const u32x4*)(src + (size_t)r * ld + c * 8); }
}
template <class F>
__device__ __forceinline__ void stage_T(const bf16_t* src, int ld, int nrows, int ncols, bf16_t* dst, int lds_ld, int tid, F f) {
    const int cgs = ncols >> 3, total = (nrows >> 1) * cgs;
    for (int idx = tid; idx < total; idx += 512) { const int rp = idx / cgs, c = idx - rp * cgs;
        const u32x4 a = *(const u32x4*)(src + (size_t)(2 * rp) * ld + c * 8), b = *(const u32x4*)(src + (size_t)(2 * rp + 1) * ld + c * 8);
        const unsigned aw[4] = {a.x, a.y, a.z, a.w}, bw[4] = {b.x, b.y, b.z, b.w};
#pragma unroll
        for (int i = 0; i < 4; ++i) {
            const int cc = c * 8 + 2 * i;
            *(unsigned*)(dst + (cc) * lds_ld + 2 * rp) = cvt_pk_bf16(f(bflo(aw[i]), 2 * rp, cc), f(bflo(bw[i]), 2 * rp + 1, cc));
            *(unsigned*)(dst + (cc + 1) * lds_ld + 2 * rp) = cvt_pk_bf16(f(bfhi(aw[i]), 2 * rp, cc + 1), f(bfhi(bw[i]), 2 * rp + 1, cc + 1));
        }
    }
}
__device__ __forceinline__ float ret_log2_gamma(int h) { return log2f(1.f - exp2f(-5.f - (float)h)); }
__device__ __forceinline__ float hgrn_lower(const float* lb, int layer, int c) {
    if (layer == 0) return 0.f;
    return 1.f / (1.f + __expf(lb[c] - lb[1024 + c]));
}

typedef short s16x4 __attribute__((ext_vector_type(4)));
__device__ __forceinline__ bf16x8 tr_frag_perm(LAS unsigned char* base, int row0, int col0, int ld, int fr, int fq) {
    const int off = ((row0 + fq * 4 + (fr >> 2)) * ld + col0 + (fr & 3) * 4) * 2;
    const s16x4 lo = __builtin_amdgcn_ds_read_tr16_b64_v4i16((LAS s16x4*)(base + off));
    const s16x4 hi = __builtin_amdgcn_ds_read_tr16_b64_v4i16((LAS s16x4*)(base + off + 16 * ld * 2));
    return __builtin_shufflevector(lo, hi, 0, 1, 2, 3, 4, 5, 6, 7);
}
__device__ __forceinline__ bf16x8 row_frag_perm(const bf16_t* M, int ld, int r0, int k0, int fr, int fq) {
    const bf16_t* q = M + (r0 + fr) * ld + k0 + fq * 4;
    const u32x2 lo = *(const u32x2*)q, hi = *(const u32x2*)(q + 16);
    u32x4 w; w.x = lo.x; w.y = lo.y; w.z = hi.x; w.w = hi.y; return __builtin_bit_cast(bf16x8, w);
}
__device__ __forceinline__ void m1_ret(const Params& p, unsigned char* lds, int item) {
    const int tid = tid_fresh(), wave = tid >> 6, lane = tid & 63, fr = lane & 15, fq = lane >> 4;
    const int bh = item >> 5, n = item & 31, b = bh >> 2, h = bh & 3;
    const bf16_t* projA = (const bf16_t*)(p.ws + WS_PROJA);
    const size_t t0 = (size_t)b * SEQ + n * 128;
    bf16_t* Vs = (bf16_t*)lds; bf16_t* Ks = (bf16_t*)(lds + 128 * 272 * 2);
    const float l2g = ret_log2_gamma(h);
    {
        const int r0 = tid >> 5, c0 = tid & 31;
        u32x4 vv[8], kv[8];
#pragma unroll
        for (int i = 0; i < 8; ++i) { vv[i] = *(const u32x4*)(projA + (t0 + r0 + 16 * i) * PA + C_RV + h * 256 + c0 * 8); kv[i] = *(const u32x4*)(projA + (t0 + r0 + 16 * i) * PA + C_RK + h * 256 + c0 * 8); }
#pragma unroll
        for (int i = 0; i < 8; ++i) { const int r = r0 + 16 * i; const float sc = exp2f(l2g * (float)(127 - r));
            *(u32x4*)(Vs + r * 272 + c0 * 8) = vv[i];
            u32x4 w; w.x = cvt_pk_bf16(bflo(kv[i].x) * sc, bfhi(kv[i].x) * sc); w.y = cvt_pk_bf16(bflo(kv[i].y) * sc, bfhi(kv[i].y) * sc);
            w.z = cvt_pk_bf16(bflo(kv[i].z) * sc, bfhi(kv[i].z) * sc); w.w = cvt_pk_bf16(bflo(kv[i].w) * sc, bfhi(kv[i].w) * sc);
            *(u32x4*)(Ks + r * 272 + c0 * 8) = w; }
    }
    __syncthreads();
    const int we = wave >> 2, wd = wave & 3;
    bf16_t* st = (bf16_t*)(p.ws + WS_STR) + (size_t)item * 65536;
    LAS unsigned char* l3 = (LAS unsigned char*)lds;
    bf16x8 bfr[4][4];
#pragma unroll
    for (int dt = 0; dt < 4; ++dt)
#pragma unroll
        for (int ks = 0; ks < 4; ++ks) bfr[dt][ks] = tr_frag_perm(l3 + 128 * 272 * 2, ks * 32, wd * 64 + dt * 16, 272, fr, fq);
    for (int et = 0; et < 8; ++et) {
        bf16x8 afr[4];
#pragma unroll
        for (int ks = 0; ks < 4; ++ks) afr[ks] = tr_frag_perm(l3, ks * 32, we * 128 + et * 16, 272, fr, fq);
        const int e = we * 128 + et * 16 + fr;
#pragma unroll
        for (int dt = 0; dt < 4; ++dt) {
            f32x4 acc = (f32x4){0.f, 0.f, 0.f, 0.f};
#pragma unroll
            for (int ks = 0; ks < 4; ++ks) acc = __builtin_amdgcn_mfma_f32_16x16x32_bf16(bfr[dt][ks], afr[ks], acc, 0, 0, 0);
            const int d = wd * 64 + dt * 16 + fq * 4;
            u32x2 w; w.x = cvt_pk_bf16(acc[0], acc[1]); w.y = cvt_pk_bf16(acc[2], acc[3]); *(u32x2*)(st + e * 256 + d) = w;
        }
    }
    __syncthreads();
}

__device__ __forceinline__ void hgrn_gates(const Params& p, int layer, const bf16_t* projA, size_t t0, int h, int d, int sg, float (&kk)[16], float (&bcl)[16]) {
    const float lbv = hgrn_lower(p.lb, layer, h * 128 + d);
    const bf16_t* src = projA + (t0 + sg * 16) * PA + C_HF + h * 128 + d;
    float hf[16];
#pragma unroll
    for (int jj = 0; jj < 16; ++jj) hf[jj] = bf2f(src[(size_t)jj * PA]);
    float run = 0.f;
#pragma unroll
    for (int jj = 0; jj < 16; ++jj) {
        const float sig = frcp_(1.f + __expf(-hf[jj]));
        const float k = (1.f - lbv) * (1.f - sig);
        kk[jj] = k;
        run += __logf(fmaxf(1.f - k, 1e-30f));
        bcl[jj] = run;
    }
}

__device__ __forceinline__ void m1_hgrn(const Params& p, int layer, unsigned char* lds, int item) {
    const int tid = tid_fresh(), wave = tid >> 6, lane = tid & 63, fr = lane & 15, fq = lane >> 4;
    const int bh = item >> 6, n = item & 63, b = bh >> 3, h = bh & 7;
    const bf16_t* projA = (const bf16_t*)(p.ws + WS_PROJA);
    const size_t t0 = (size_t)b * SEQ + n * 64;
    float* TOT = (float*)lds;
    bf16_t* Vs = (bf16_t*)(lds + 2048);
    bf16_t* Kd = (bf16_t*)(lds + 2048 + 18432);
    const int d = tid & 127, sg = tid >> 7;
    const int vr = tid >> 4, vc = tid & 15;
    const u32x4 v0 = *(const u32x4*)(projA + (t0 + vr) * PA + C_HI + h * 128 + vc * 8), v1 = *(const u32x4*)(projA + (t0 + vr + 32) * PA + C_HI + h * 128 + vc * 8);
    float kk[16], bcl[16];
    hgrn_gates(p, layer, projA, t0, h, d, sg, kk, bcl);
    TOT[sg * 128 + d] = bcl[15];
    *(u32x4*)(Vs + vr * 144 + vc * 8) = v0; *(u32x4*)(Vs + (vr + 32) * 144 + vc * 8) = v1;
    __syncthreads();
    {
        float tail = 0.f;
        for (int s2 = 3; s2 > sg; --s2) tail += TOT[s2 * 128 + d];
        const float tot = bcl[15] + tail;
#pragma unroll
        for (int jj = 0; jj < 16; ++jj) Kd[(sg * 16 + jj) * 144 + d] = (bf16_t)(cvt_pk_bf16(kk[jj] * __expf(tot - bcl[jj]), 0.f) & 0xffffu);
        if (sg == 0) ((float*)(p.ws + WS_HDEC))[(size_t)item * 128 + d] = __expf(tot);
    }
    __syncthreads();
    const int we = wave >> 2, wd = wave & 3;
    bf16_t* st = (bf16_t*)(p.ws + WS_STH) + (size_t)item * 16384;
    LAS unsigned char* l3 = (LAS unsigned char*)lds;
    bf16x8 bfr[2][2];
#pragma unroll
    for (int dt = 0; dt < 2; ++dt)
#pragma unroll
        for (int ks = 0; ks < 2; ++ks) bfr[dt][ks] = tr_frag_perm(l3 + 2048 + 18432, ks * 32, wd * 32 + dt * 16, 144, fr, fq);
#pragma unroll
    for (int et = 0; et < 4; ++et) {
        bf16x8 afr[2];
#pragma unroll
        for (int ks = 0; ks < 2; ++ks) afr[ks] = tr_frag_perm(l3 + 2048, ks * 32, we * 64 + et * 16, 144, fr, fq);
#pragma unroll
        for (int dt = 0; dt < 2; ++dt) {
            f32x4 acc = (f32x4){0.f, 0.f, 0.f, 0.f};
#pragma unroll
            for (int ks = 0; ks < 2; ++ks) acc = __builtin_amdgcn_mfma_f32_16x16x32_bf16(bfr[dt][ks], afr[ks], acc, 0, 0, 0);
            const int e = we * 64 + et * 16 + fr, dd = wd * 32 + dt * 16 + fq * 4;
            u32x2 w; w.x = cvt_pk_bf16(acc[0], acc[1]); w.y = cvt_pk_bf16(acc[2], acc[3]); *(u32x2*)(st + e * 128 + dd) = w;
        }
    }
    __syncthreads();
}

__device__ __forceinline__ void m1_kmean(const Params& p, unsigned char* lds, int item) {
    const int tid = tid_fresh();
    const int bh = item >> 4, blk = item & 15, b = bh >> 3, h = bh & 7;
    const bf16_t* projA = (const bf16_t*)(p.ws + WS_PROJA);
    const size_t t0 = (size_t)b * SEQ + blk * 256;
    const int c = tid & 15, rg = tid >> 4;
    u32x4 kv[8];
#pragma unroll
    for (int i = 0; i < 8; ++i) kv[i] = *(const u32x4*)(projA + (t0 + rg + 32 * i) * PA + C_MK + h * 128 + c * 8);
    float s[8] = {0.f, 0.f, 0.f, 0.f, 0.f, 0.f, 0.f, 0.f};
#pragma unroll
    for (int i = 0; i < 8; ++i) { s[0] += bflo(kv[i].x); s[1] += bfhi(kv[i].x); s[2] += bflo(kv[i].y); s[3] += bfhi(kv[i].y); s[4] += bflo(kv[i].z); s[5] += bfhi(kv[i].z); s[6] += bflo(kv[i].w); s[7] += bfhi(kv[i].w); }
    float* red = (float*)lds;
#pragma unroll
    for (int j = 0; j < 8; ++j) red[rg * 128 + c * 8 + j] = s[j];
    __syncthreads();
    if (tid < 128) { float t = 0.f;
#pragma unroll 8
        for (int r = 0; r < 32; ++r) t += red[r * 128 + tid];
        ((float*)(p.ws + WS_KMEAN))[(size_t)item * 128 + tid] = t * (1.f / 256.f); }
    __syncthreads();
}

__device__ __forceinline__ void m1_phase(const Params& p, int layer, unsigned char* lds) {
    for (int it = blockIdx.x; it < 512 + 2048 + 512; it += gridDim.x) {
        if (it < 512) m1_ret(p, lds, it);
        else if (it < 2560) m1_hgrn(p, layer, lds, it - 512);
        else m1_kmean(p, lds, it - 2560);
    }
}

__device__ __forceinline__ void m2_phase(const Params& p) {
    const int gt = blockIdx.x * 512 + tid_fresh(), ngt = gridDim.x * 512;
    for (int idx = gt; idx < 16 * 8192; idx += ngt) {
        const int bh = idx >> 13, off = (idx & 8191) * 8, h = bh & 3;
        const float cd = exp2f(ret_log2_gamma(h) * 128.f);
        bf16_t* base = (bf16_t*)(p.ws + WS_STR) + (size_t)bh * 32 * 65536 + off;
        float st[8];
#pragma unroll
        for (int i = 0; i < 8; ++i) st[i] = 0.f;
        for (int n0 = 0; n0 < 32; n0 += 8) {
            u32x4 kv[8];
#pragma unroll
            for (int j = 0; j < 8; ++j) kv[j] = *(const u32x4*)(base + (size_t)(n0 + j) * 65536);
#pragma unroll
            for (int j = 0; j < 8; ++j) {
                u32x4 o; o.x = cvt_pk_bf16(st[0], st[1]); o.y = cvt_pk_bf16(st[2], st[3]); o.z = cvt_pk_bf16(st[4], st[5]); o.w = cvt_pk_bf16(st[6], st[7]);
                *(u32x4*)(base + (size_t)(n0 + j) * 65536) = o;
                st[0] = cd * st[0] + bflo(kv[j].x); st[1] = cd * st[1] + bfhi(kv[j].x); st[2] = cd * st[2] + bflo(kv[j].y); st[3] = cd * st[3] + bfhi(kv[j].y);
                st[4] = cd * st[4] + bflo(kv[j].z); st[5] = cd * st[5] + bfhi(kv[j].z); st[6] = cd * st[6] + bflo(kv[j].w); st[7] = cd * st[7] + bfhi(kv[j].w);
            }
        }
    }
    for (int idx = gt; idx < 32 * 4096; idx += ngt) {
        const int bh = idx >> 12, off = (idx & 4095) * 4, d = off & 127;
        bf16_t* base = (bf16_t*)(p.ws + WS_STH) + (size_t)bh * 64 * 16384 + off;
        const float* dec = (const float*)(p.ws + WS_HDEC) + (size_t)bh * 64 * 128 + d;
        float st[4] = {0.f, 0.f, 0.f, 0.f};
        for (int n0 = 0; n0 < 64; n0 += 8) {
            u32x2 kv[8]; f32x4 dc[8];
#pragma unroll
            for (int j = 0; j < 8; ++j) { kv[j] = *(const u32x2*)(base + (size_t)(n0 + j) * 16384); dc[j] = *(const f32x4*)(dec + (n0 + j) * 128); }
#pragma unroll
            for (int j = 0; j < 8; ++j) {
                u32x2 o; o.x = cvt_pk_bf16(st[0], st[1]); o.y = cvt_pk_bf16(st[2], st[3]);
                *(u32x2*)(base + (size_t)(n0 + j) * 16384) = o;
                st[0] = dc[j].x * st[0] + bflo(kv[j].x); st[1] = dc[j].y * st[1] + bfhi(kv[j].x); st[2] = dc[j].z * st[2] + bflo(kv[j].y); st[3] = dc[j].w * st[3] + bfhi(kv[j].y);
            }
        }
    }
}

__device__ __forceinline__ void m3_ret(const Params& p, int layer, unsigned char* lds, int item) {
    const int tid = tid_fresh(), wave = tid >> 6, lane = tid & 63, fr = lane & 15, fq = lane >> 4;
    const int bh = item >> 5, n = item & 31, b = bh >> 2, h = bh & 3;
    const bf16_t* projA = (const bf16_t*)(p.ws + WS_PROJA);
    const size_t t0 = (size_t)b * SEQ + n * 128;
    bf16_t* R2 = (bf16_t*)lds;
    bf16_t* Ps = (bf16_t*)(lds + 69632);
    float* ST = (float*)(lds + 69632 + 34816);
    const float l2g = ret_log2_gamma(h);
    const int wi = wave >> 1, wc = wave & 1;
    const int cr = tid >> 5, cc = tid & 31;
    bf16x8 qf[2][8];
#pragma unroll
    for (int it = 0; it < 2; ++it)
#pragma unroll
        for (int ks = 0; ks < 8; ++ks) qf[it][ks] = *(const bf16x8*)(projA + (t0 + wi * 32 + it * 16 + fr) * PA + C_RQ + h * 256 + ks * 32 + fq * 8);
    u32x4 rr[8];
#pragma unroll
    for (int i = 0; i < 8; ++i) rr[i] = *(const u32x4*)(projA + (t0 + cr + 16 * i) * PA + C_RK + h * 256 + cc * 8);
#pragma unroll
    for (int i = 0; i < 8; ++i) *(u32x4*)(R2 + (cr + 16 * i) * 264 + cc * 8) = rr[i];
    const bf16_t* stg = (const bf16_t*)(p.ws + WS_STR) + (size_t)item * 65536;
#pragma unroll
    for (int i = 0; i < 8; ++i) rr[i] = *(const u32x4*)(stg + (size_t)(cr + 16 * i) * 256 + cc * 8);
    __syncthreads();
#pragma unroll
    for (int it = 0; it < 2; ++it)
#pragma unroll
        for (int jt = 0; jt < 4; ++jt) {
            const int jb = wc * 64 + jt * 16, ib = wi * 32 + it * 16;
            f32x4 a = (f32x4){0.f, 0.f, 0.f, 0.f};
            if (jb <= ib + 15) {
#pragma unroll
                for (int ks = 0; ks < 8; ++ks) { const bf16x8 kf = *(const bf16x8*)(R2 + (jb + fr) * 264 + ks * 32 + fq * 8);
                    a = __builtin_amdgcn_mfma_f32_16x16x32_bf16(kf, qf[it][ks], a, 0, 0, 0); }
            }
            const int i = ib + fr, j0 = jb + fq * 4;
            float pv[4];
#pragma unroll
            for (int jj = 0; jj < 4; ++jj) { const int rel = i - (j0 + jj); pv[jj] = rel >= 0 ? a[jj] * exp2f(l2g * (float)rel) : 0.f; }
            u32x2 w; w.x = cvt_pk_bf16(pv[0], pv[1]); w.y = cvt_pk_bf16(pv[2], pv[3]); *(u32x2*)(Ps + i * 136 + j0) = w;
        }
    __syncthreads();
    f32x4 acc[2][2][4];
#pragma unroll
    for (int a = 0; a < 2; ++a)
#pragma unroll
        for (int e = 0; e < 2; ++e)
#pragma unroll
            for (int t = 0; t < 4; ++t) acc[a][e][t] = (f32x4){0.f, 0.f, 0.f, 0.f};
#pragma unroll
    for (int eh = 0; eh < 2; ++eh) {
#pragma unroll
        for (int i = 0; i < 8; ++i) *(u32x4*)(R2 + (cr + 16 * i) * 264 + cc * 8) = rr[i];
        if (eh == 0) {
#pragma unroll
            for (int i = 0; i < 8; ++i) rr[i] = *(const u32x4*)(stg + (size_t)(128 + cr + 16 * i) * 256 + cc * 8);
        } else {
#pragma unroll
            for (int i = 0; i < 8; ++i) rr[i] = *(const u32x4*)(projA + (t0 + cr + 16 * i) * PA + C_RV + h * 256 + cc * 8);
        }
        __syncthreads();
#pragma unroll
        for (int e4 = 0; e4 < 4; ++e4)
#pragma unroll
            for (int ks = 0; ks < 8; ++ks) { const bf16x8 rf = *(const bf16x8*)(R2 + (wc * 64 + e4 * 16 + fr) * 264 + ks * 32 + fq * 8);
#pragma unroll
                for (int it = 0; it < 2; ++it) acc[it][eh][e4] = __builtin_amdgcn_mfma_f32_16x16x32_bf16(rf, qf[it][ks], acc[it][eh][e4], 0, 0, 0); }
        __syncthreads();
    }
#pragma unroll
    for (int it = 0; it < 2; ++it) { const float sc = exp2f(l2g * (float)(wi * 32 + it * 16 + fr + 1));
#pragma unroll
        for (int e = 0; e < 2; ++e)
#pragma unroll
            for (int t = 0; t < 4; ++t) acc[it][e][t] *= sc; }
#pragma unroll
    for (int i = 0; i < 8; ++i) *(u32x4*)(R2 + (cr + 16 * i) * 272 + cc * 8) = rr[i];
    __syncthreads();
    {
        LAS unsigned char* l3 = (LAS unsigned char*)lds;
#pragma unroll
        for (int ks = 0; ks < 4; ++ks) {
            bf16x8 pa[2];
#pragma unroll
            for (int it = 0; it < 2; ++it) pa[it] = row_frag_perm(Ps, 136, wi * 32 + it * 16, ks * 32, fr, fq);
#pragma unroll
            for (int eh = 0; eh < 2; ++eh)
#pragma unroll
                for (int e4 = 0; e4 < 4; ++e4) { const bf16x8 vb = tr_frag_perm(l3, ks * 32, eh * 128 + wc * 64 + e4 * 16, 272, fr, fq);
#pragma unroll
                    for (int it = 0; it < 2; ++it) acc[it][eh][e4] = __builtin_amdgcn_mfma_f32_16x16x32_bf16(vb, pa[it], acc[it][eh][e4], 0, 0, 0); }
        }
    }
#pragma unroll
    for (int it = 0; it < 2; ++it) {
        float s = 0.f, s2 = 0.f;
#pragma unroll
        for (int e = 0; e < 2; ++e)
#pragma unroll
            for (int t = 0; t < 4; ++t)
#pragma unroll
                for (int j = 0; j < 4; ++j) { const float v = acc[it][e][t][j]; s += v; s2 += v * v; }
        s += __shfl_xor(s, 16); s += __shfl_xor(s, 32); s2 += __shfl_xor(s2, 16); s2 += __shfl_xor(s2, 32);
        if (fq == 0) { ST[((wi * 32 + it * 16 + fr) * 2 + wc) * 2] = s; ST[((wi * 32 + it * 16 + fr) * 2 + wc) * 2 + 1] = s2; }
    }
    __syncthreads();
    bf16_t* ro = (bf16_t*)(p.ws + WS_BOUT);
    const float* rn = p.ret_norm + (size_t)layer * 1024 + h * 256;
#pragma unroll
    for (int it = 0; it < 2; ++it) {
        const int i = wi * 32 + it * 16 + fr;
        const float s = ST[i * 4] + ST[i * 4 + 2], s2 = ST[i * 4 + 1] + ST[i * 4 + 3];
        const float mu = s * (1.f / 256.f), var = fmaxf(s2 * (1.f / 256.f) - mu * mu, 0.f), rstd = __builtin_amdgcn_rsqf(var + EPS);
        const size_t tok = t0 + i;
#pragma unroll
        for (int eh = 0; eh < 2; ++eh)
#pragma unroll
            for (int e4 = 0; e4 < 4; ++e4) {
                const int e = eh * 128 + wc * 64 + e4 * 16 + fq * 4;
                const u32x2 g = *(const u32x2*)(projA + tok * PA + C_RG + h * 256 + e);
                const f32x4 nn = *(const f32x4*)(rn + e);
                const f32x4 v = acc[it][eh][e4];
                const float o0 = (v[0] - mu) * rstd * nn[0] * siluf_(bflo(g.x)), o1 = (v[1] - mu) * rstd * nn[1] * siluf_(bfhi(g.x));
                const float o2 = (v[2] - mu) * rstd * nn[2] * siluf_(bflo(g.y)), o3 = (v[3] - mu) * rstd * nn[3] * siluf_(bfhi(g.y));
                u32x2 w; w.x = cvt_pk_bf16(o0, o1); w.y = cvt_pk_bf16(o2, o3);
                *(u32x2*)(ro + tok * 1024 + h * 256 + e) = w;
            }
    }
    __syncthreads();
}

__device__ __forceinline__ void m3_hgrn(const Params& p, int layer, unsigned char* lds, int item) {
    const int tid = tid_fresh(), wave = tid >> 6, lane = tid & 63, fr = lane & 15, fq = lane >> 4;
    const int bh = item >> 6, n = item & 63, b = bh >> 3, h = bh & 7;
    const bf16_t* projA = (const bf16_t*)(p.ws + WS_PROJA);
    const size_t t0 = (size_t)b * SEQ + n * 64;
    float* TOT = (float*)lds;
    bf16_t* Qb = (bf16_t*)(lds + 2048);
    bf16_t* Qe = (bf16_t*)(lds + 19456);
    bf16_t* Ke = (bf16_t*)(lds + 36864);
    bf16_t* Ss = (bf16_t*)(lds + 80384);
    bf16_t* Vs = (bf16_t*)(lds + 115200);
    bf16_t* Ps = (bf16_t*)(lds + 133632);
    float* ST = (float*)(lds + 142848);
    const int d = tid & 127, sg = tid >> 7;
    const int vr = tid >> 4, vc = tid & 15;
    const u32x4 v0 = *(const u32x4*)(projA + (t0 + vr) * PA + C_HI + h * 128 + vc * 8), v1 = *(const u32x4*)(projA + (t0 + vr + 32) * PA + C_HI + h * 128 + vc * 8);
    const bf16_t* sgl = (const bf16_t*)(p.ws + WS_STH) + (size_t)item * 16384;
    u32x4 sv[4];
#pragma unroll
    for (int i = 0; i < 4; ++i) sv[i] = *(const u32x4*)(sgl + (vr + 32 * i) * 128 + vc * 8);
    float qv[16];
    { const bf16_t* src = projA + (t0 + sg * 16) * PA + C_HQ + h * 128 + d;
#pragma unroll
      for (int jj = 0; jj < 16; ++jj) qv[jj] = bf2f(src[(size_t)jj * PA]); }
    float kk[16], bcl[16];
    hgrn_gates(p, layer, projA, t0, h, d, sg, kk, bcl);
    TOT[sg * 128 + d] = bcl[15];
    *(u32x4*)(Vs + vr * 144 + vc * 8) = v0; *(u32x4*)(Vs + (vr + 32) * 144 + vc * 8) = v1;
#pragma unroll
    for (int i = 0; i < 4; ++i) *(u32x4*)(Ss + (vr + 32 * i) * 136 + vc * 8) = sv[i];
    __syncthreads();
    {
        const float T0 = TOT[d], T1 = TOT[128 + d], T2 = TOT[256 + d];
        const float Bsg = sg == 0 ? 0.f : (sg == 1 ? T0 : (sg == 2 ? T0 + T1 : T0 + T1 + T2));
        const float r1 = sg == 0 ? T0 : (sg == 1 ? T1 : T2);
        const float r2 = sg == 0 ? T0 + T1 : T1 + T2;
        const float r3 = T0 + T1 + T2;
#pragma unroll
        for (int jj = 0; jj < 16; ++jj) {
            const int i = sg * 16 + jj;
            const float q = qv[jj] * frcp_(1.f + __expf(-qv[jj]));
            Qb[i * 136 + d] = (bf16_t)(cvt_pk_bf16(q * __expf(Bsg + bcl[jj]), 0.f) & 0xffffu);
            Qe[i * 136 + d] = (bf16_t)(cvt_pk_bf16(q * __expf(fmaxf(bcl[jj], -80.f)), 0.f) & 0xffffu);
            Ke[(8 * sg * (sg + 1) + i) * 136 + d] = (bf16_t)(cvt_pk_bf16(kk[jj] * __expf(fminf(-bcl[jj], 80.f)), 0.f) & 0xffffu);
            if (sg < 3) Ke[(8 * (sg + 1) * (sg + 2) + i) * 136 + d] = (bf16_t)(cvt_pk_bf16(kk[jj] * __expf(r1 - bcl[jj]), 0.f) & 0xffffu);
            if (sg < 2) Ke[(8 * (sg + 2) * (sg + 3) + i) * 136 + d] = (bf16_t)(cvt_pk_bf16(kk[jj] * __expf(r2 - bcl[jj]), 0.f) & 0xffffu);
            if (sg < 1) Ke[(96 + i) * 136 + d] = (bf16_t)(cvt_pk_bf16(kk[jj] * __expf(r3 - bcl[jj]), 0.f) & 0xffffu);
        }
    }
    __syncthreads();
    const int wi = wave >> 2, wc = wave & 3;
    f32x4 acc[2][2];
#pragma unroll
    for (int it = 0; it < 2; ++it)
#pragma unroll
        for (int et = 0; et < 2; ++et) { acc[it][et] = (f32x4){0.f, 0.f, 0.f, 0.f};
            acc[it][et] = mma_tile<true>(Qb + (wi * 32 + it * 16) * 136, 136, Ss + (wc * 32 + et * 16) * 136, 136, 4, acc[it][et], lane); }
#pragma unroll
    for (int tt = 0; tt < 2; ++tt) {
        const int tix = wave * 2 + tt, I = tix >> 2, J = tix & 3;
        f32x4 a = (f32x4){0.f, 0.f, 0.f, 0.f};
        if (J <= I) a = mma_tile<true>(Qe + (I * 16) * 136, 136, Ke + (8 * I * (I + 1) + J * 16) * 136, 136, 4, a, lane);
        const int i = I * 16 + fr, j0 = J * 16 + fq * 4;
        float pv[4];
#pragma unroll
        for (int jj = 0; jj < 4; ++jj) pv[jj] = (J <= I && j0 + jj <= i) ? a[jj] : 0.f;
        u32x2 w; w.x = cvt_pk_bf16(pv[0], pv[1]); w.y = cvt_pk_bf16(pv[2], pv[3]); *(u32x2*)(Ps + i * 72 + j0) = w;
    }
    __syncthreads();
    {
        LAS unsigned char* l3 = (LAS unsigned char*)lds;
#pragma unroll
        for (int ks = 0; ks < 2; ++ks) {
            bf16x8 pa[2], vb[2];
#pragma unroll
            for (int it = 0; it < 2; ++it) pa[it] = row_frag_perm(Ps, 72, wi * 32 + it * 16, ks * 32, fr, fq);
#pragma unroll
            for (int et = 0; et < 2; ++et) vb[et] = tr_frag_perm(l3 + 115200, ks * 32, wc * 32 + et * 16, 144, fr, fq);
#pragma unroll
            for (int it = 0; it < 2; ++it)
#pragma unroll
                for (int et = 0; et < 2; ++et) acc[it][et] = __builtin_amdgcn_mfma_f32_16x16x32_bf16(vb[et], pa[it], acc[it][et], 0, 0, 0);
        }
    }
#pragma unroll
    for (int it = 0; it < 2; ++it) {
        float s2 = 0.f;
#pragma unroll
        for (int t = 0; t < 2; ++t)
#pragma unroll
            for (int j = 0; j < 4; ++j) { const float v = acc[it][t][j]; s2 += v * v; }
        s2 += __shfl_xor(s2, 16); s2 += __shfl_xor(s2, 32);
        if (fq == 0) ST[(wi * 32 + it * 16 + fr) * 4 + wc] = s2;
    }
    __syncthreads();
    bf16_t* ho = (bf16_t*)(p.ws + WS_BOUT) + (size_t)2 * NTOK * 1024;
    const float* hn = p.hgrn_norm + (size_t)layer * 1024 + h * 128;
#pragma unroll
    for (int it = 0; it < 2; ++it) {
        const int i = wi * 32 + it * 16 + fr;
        const float s2 = ST[i * 4] + ST[i * 4 + 1] + ST[i * 4 + 2] + ST[i * 4 + 3];
        const float rstd = __builtin_amdgcn_rsqf(s2 * (1.f / 128.f) + EPS);
        const size_t tok = t0 + i;
#pragma unroll
        for (int et = 0; et < 2; ++et) {
            const int e = wc * 32 + et * 16 + fq * 4;
            const u32x2 g = *(const u32x2*)(projA + tok * PA + C_HG + h * 128 + e);
            const f32x4 nn = *(const f32x4*)(hn + e);
            const f32x4 v = acc[it][et];
            u32x2 w; w.x = cvt_pk_bf16(v[0] * rstd * nn[0] * siluf_(bflo(g.x)), v[1] * rstd * nn[1] * siluf_(bfhi(g.x)));
            w.y = cvt_pk_bf16(v[2] * rstd * nn[2] * siluf_(bflo(g.y)), v[3] * rstd * nn[3] * siluf_(bfhi(g.y)));
            *(u32x2*)(ho + tok * 1024 + h * 128 + e) = w;
        }
    }
    __syncthreads();
}

__device__ __forceinline__ void m3_moba(const Params& p, unsigned char* lds, int item) {
    const int tid = tid_fresh(), wave = tid >> 6, lane = tid & 63, fr = lane & 15, fq = lane >> 4;
    const int bh = item & 31, qb = 15 - (item >> 5), b = bh >> 3, h = bh & 7;
    const bf16_t* projA = (const bf16_t*)(p.ws + WS_PROJA);
    const size_t tb = (size_t)b * SEQ;
    const int q0 = qb * 256;
    bf16_t* Qs = (bf16_t*)lds;
    float* KM = (float*)(lds + 69632);
    int* SEL = (int*)(lds + 77824);
    constexpr int KVB = 78912 + 1024, KVSZ = 17408 + 18432;
    stage_copy(projA + (tb + q0) * PA + C_MQ + h * 128, PA, 256, 128, Qs, 136, tid);
    { const float* km = (const float*)(p.ws + WS_KMEAN) + (size_t)bh * 2048; for (int i = tid; i < 2048; i += 512) KM[i] = km[i]; }
    if (tid == 0) SEL[256] = 0;
    __syncthreads();
    if (tid < 256) {
        float best0 = -INFINITY, best1 = -INFINITY, best2 = -INFINITY; int i0 = -1, i1 = -1, i2 = -1;
        for (int blk = 0; blk < qb; ++blk) {
            float sa = 0.f;
            for (int dd = 0; dd < 128; dd += 8) { const u32x4 qv = *(const u32x4*)(Qs + tid * 136 + dd); const float* kk = KM + blk * 128 + dd;
                sa += bflo(qv.x) * kk[0] + bfhi(qv.x) * kk[1] + bflo(qv.y) * kk[2] + bfhi(qv.y) * kk[3] + bflo(qv.z) * kk[4] + bfhi(qv.z) * kk[5] + bflo(qv.w) * kk[6] + bfhi(qv.w) * kk[7]; }
            if (sa > best0) { best2 = best1; i2 = i1; best1 = best0; i1 = i0; best0 = sa; i0 = blk; }
            else if (sa > best1) { best2 = best1; i2 = i1; best1 = sa; i1 = blk; }
            else if (sa > best2) { best2 = sa; i2 = blk; }
        }
        int mask = 0; if (i0 >= 0) mask |= 1 << i0; if (i1 >= 0) mask |= 1 << i1; if (i2 >= 0) mask |= 1 << i2;
        SEL[tid] = mask; atomicOr(&SEL[256], mask);
    }
    bf16x8 qf[2][4];
#pragma unroll
    for (int gi = 0; gi < 2; ++gi)
#pragma unroll
        for (int ks = 0; ks < 4; ++ks) qf[gi][ks] = *(const bf16x8*)(Qs + (wave * 32 + gi * 16 + fr) * 136 + ks * 32 + fq * 8);
    __syncthreads();
    if (tid == 0) {
        const int um = SEL[256]; int n = 0;
        for (int kt = 0; kt < 4; ++kt) SEL[264 + n++] = q0 + kt * 64;
        for (int kb = 0; kb < qb; ++kb) if ((um >> kb) & 1) for (int kt = 0; kt < 4; ++kt) SEL[264 + n++] = kb * 256 + kt * 64;
        SEL[257] = n;
    }
    __syncthreads();
    const int ntl = SEL[257];
    int mysel[2], qpos[2];
#pragma unroll
    for (int gi = 0; gi < 2; ++gi) { mysel[gi] = SEL[wave * 32 + gi * 16 + fr]; qpos[gi] = q0 + wave * 32 + gi * 16 + fr; }
    const float sl2 = 0.08838834764831845f * 1.4426950408889634f;
    float mneg[2] = {0.f, 0.f}, lrun[2] = {0.f, 0.f};
    f32x4 o[2][8];
#pragma unroll
    for (int gi = 0; gi < 2; ++gi)
#pragma unroll
        for (int et = 0; et < 8; ++et) o[gi][et] = (f32x4){0.f, 0.f, 0.f, 0.f};
    const int r0 = tid >> 4, c0 = tid & 15;
    const bf16_t* kg = projA + tb * PA + C_MK + h * 128 + c0 * 8;
    const bf16_t* vg = projA + tb * PA + C_MV + h * 128 + c0 * 8;
    u32x4 kr0, kr1, vr0, vr1;
    { const int key0 = SEL[264];
      kr0 = *(const u32x4*)(kg + (size_t)(key0 + r0) * PA); kr1 = *(const u32x4*)(kg + (size_t)(key0 + r0 + 32) * PA);
      vr0 = *(const u32x4*)(vg + (size_t)(key0 + r0) * PA); vr1 = *(const u32x4*)(vg + (size_t)(key0 + r0 + 32) * PA);
      bf16_t* Kb = (bf16_t*)(lds + KVB); bf16_t* Vb = (bf16_t*)(lds + KVB + 17408);
      *(u32x4*)(Kb + r0 * 136 + c0 * 8) = kr0; *(u32x4*)(Kb + (r0 + 32) * 136 + c0 * 8) = kr1;
      *(u32x4*)(Vb + r0 * 144 + c0 * 8) = vr0; *(u32x4*)(Vb + (r0 + 32) * 144 + c0 * 8) = vr1; }
    __syncthreads();
    for (int t = 0; t < ntl; ++t) {
        const int key0 = SEL[264 + t];
        const bool more = t + 1 < ntl;
        if (more) { const int kn = SEL[264 + t + 1];
            kr0 = *(const u32x4*)(kg + (size_t)(kn + r0) * PA); kr1 = *(const u32x4*)(kg + (size_t)(kn + r0 + 32) * PA);
            vr0 = *(const u32x4*)(vg + (size_t)(kn + r0) * PA); vr1 = *(const u32x4*)(vg + (size_t)(kn + r0 + 32) * PA); }
        const bf16_t* Kb = (const bf16_t*)(lds + KVB + (t & 1) * KVSZ); const bf16_t* Vb = Kb + 17408 / 2;
        const bool own = key0 >= q0; const int kb = key0 >> 8;
        if (!(own && key0 > q0 + wave * 32 + 31)) {
            f32x4 s[2][4];
            {
                bf16x8 kf[4][4];
#pragma unroll
                for (int nt = 0; nt < 4; ++nt)
#pragma unroll
                    for (int ks = 0; ks < 4; ++ks) kf[nt][ks] = *(const bf16x8*)(Kb + (nt * 16 + fr) * 136 + ks * 32 + fq * 8);
                __builtin_amdgcn_sched_barrier(0);
#pragma unroll
                for (int nt = 0; nt < 4; ++nt) { s[0][nt] = (f32x4){0.f, 0.f, 0.f, 0.f}; s[1][nt] = (f32x4){0.f, 0.f, 0.f, 0.f}; }
#pragma unroll
                for (int ks = 0; ks < 4; ++ks)
#pragma unroll
                    for (int nt = 0; nt < 4; ++nt) {
                        s[0][nt] = __builtin_amdgcn_mfma_f32_16x16x32_bf16(kf[nt][ks], qf[0][ks], s[0][nt], 0, 0, 0);
                        s[1][nt] = __builtin_amdgcn_mfma_f32_16x16x32_bf16(kf[nt][ks], qf[1][ks], s[1][nt], 0, 0, 0); }
            }
            bf16x8 pf[2][2];
#pragma unroll
            for (int gi = 0; gi < 2; ++gi) {
                if (t == 0) {
                    float mt = -INFINITY;
#pragma unroll
                    for (int nt = 0; nt < 4; ++nt)
#pragma unroll
                        for (int j = 0; j < 4; ++j) { const int key = key0 + nt * 16 + fq * 4 + j; mt = fmaxf(mt, key <= qpos[gi] ? s[gi][nt][j] * sl2 : -INFINITY); }
                    mt = fmaxf(mt, __shfl_xor(mt, 16)); mt = fmaxf(mt, __shfl_xor(mt, 32));
                    mneg[gi] = -mt;
                }
                float ls = 0.f;
                if (own) {
#pragma unroll
                    for (int nt = 0; nt < 4; ++nt)
#pragma unroll
                        for (int j = 0; j < 4; ++j) { const int key = key0 + nt * 16 + fq * 4 + j;
                            const float pv = __builtin_amdgcn_exp2f(key <= qpos[gi] ? __builtin_fmaf(s[gi][nt][j], sl2, mneg[gi]) : -INFINITY); s[gi][nt][j] = pv; ls += pv; }
                } else {
                    const float bias = ((mysel[gi] >> kb) & 1) ? mneg[gi] : -1e30f;
#pragma unroll
                    for (int nt = 0; nt < 4; ++nt)
#pragma unroll
                        for (int j = 0; j < 4; ++j) { const float pv = __builtin_amdgcn_exp2f(__builtin_fmaf(s[gi][nt][j], sl2, bias)); s[gi][nt][j] = pv; ls += pv; }
                }
                lrun[gi] += ls;
#pragma unroll
                for (int s2 = 0; s2 < 2; ++s2) { u32x4 pw; pw.x = cvt_pk_bf16(s[gi][2 * s2][0], s[gi][2 * s2][1]); pw.y = cvt_pk_bf16(s[gi][2 * s2][2], s[gi][2 * s2][3]);
                    pw.z = cvt_pk_bf16(s[gi][2 * s2 + 1][0], s[gi][2 * s2 + 1][1]); pw.w = cvt_pk_bf16(s[gi][2 * s2 + 1][2], s[gi][2 * s2 + 1][3]); pf[gi][s2] = __builtin_bit_cast(bf16x8, pw); }
            }
#pragma unroll
            for (int s2 = 0; s2 < 2; ++s2) {
                LAS unsigned char* vbase = (LAS unsigned char*)lds + KVB + (t & 1) * KVSZ + 17408;
                bf16x8 vf[8];
#pragma unroll
                for (int et = 0; et < 8; ++et) {
                    const int voff = ((s2 * 32 + fq * 4 + (fr >> 2)) * 144 + et * 16 + (fr & 3) * 4) * 2;
                    const s16x4 lo = __builtin_amdgcn_ds_read_tr16_b64_v4i16((LAS s16x4*)(vbase + voff));
                    const s16x4 hi = __builtin_amdgcn_ds_read_tr16_b64_v4i16((LAS s16x4*)(vbase + voff + 16 * 144 * 2));
                    vf[et] = __builtin_shufflevector(lo, hi, 0, 1, 2, 3, 4, 5, 6, 7);
                }
                __builtin_amdgcn_sched_barrier(0);
#pragma unroll
                for (int et = 0; et < 8; ++et) {
                    o[0][et] = __builtin_amdgcn_mfma_f32_16x16x32_bf16(vf[et], pf[0][s2], o[0][et], 0, 0, 0);
                    o[1][et] = __builtin_amdgcn_mfma_f32_16x16x32_bf16(vf[et], pf[1][s2], o[1][et], 0, 0, 0);
                }
            }
        }
        if (more) { bf16_t* Kn = (bf16_t*)(lds + KVB + ((t + 1) & 1) * KVSZ); bf16_t* Vn = Kn + 17408 / 2;
            *(u32x4*)(Kn + r0 * 136 + c0 * 8) = kr0; *(u32x4*)(Kn + (r0 + 32) * 136 + c0 * 8) = kr1;
            *(u32x4*)(Vn + r0 * 144 + c0 * 8) = vr0; *(u32x4*)(Vn + (r0 + 32) * 144 + c0 * 8) = vr1; }
        __syncthreads();
    }
    bf16_t* mo = (bf16_t*)(p.ws + WS_BOUT) + (size_t)NTOK * 1024;
#pragma unroll
    for (int gi = 0; gi < 2; ++gi) {
        float l = lrun[gi]; l += __shfl_xor(l, 16); l += __shfl_xor(l, 32);
        const float inv = 1.f / l;
        const size_t tok = tb + qpos[gi];
#pragma unroll
        for (int et = 0; et < 8; ++et) {
            u32x2 w; w.x = cvt_pk_bf16(o[gi][et][0] * inv, o[gi][et][1] * inv); w.y = cvt_pk_bf16(o[gi][et][2] * inv, o[gi][et][3] * inv);
            *(u32x2*)(mo + tok * 1024 + h * 128 + et * 16 + fq * 4) = w;
        }
    }
    __syncthreads();
}

__device__ __forceinline__ void m3_phase(const Params& p, int layer, unsigned char* lds, int rep = 0, int lo = 0, int hi = 3072) {
    unsigned* ctr = (unsigned*)(p.ws + WS_CTR) + layer * 16 + rep * 4;
    int* slot = (int*)(lds + LDS_ITEM_OFF);
    for (;;) {
        if (threadIdx.x == 0) *slot = (int)atomicAdd(ctr, 1u);
        __syncthreads();
        const int it = *slot + lo;
        __syncthreads();
        if (it >= hi) break;
        if (it < 512) m3_moba(p, lds, it);
        else if (it < 1024) m3_ret(p, layer, lds, it - 512);
        else m3_hgrn(p, layer, lds, it - 1024);
    }
}

__device__ __forceinline__ void final_norm_phase(const Params& p) {
    const int tid = tid_fresh(), wave = tid >> 6, lane = tid & 63;
    const int gw = blockIdx.x * 8 + wave, ngw = gridDim.x * 8;
    for (int r = gw; r < NTOK; r += ngw) {
        f32x4* xr = (f32x4*)(p.out + (size_t)r * DM) + lane;
        f32x4 v[8]; float s = 0.f;
#pragma unroll
        for (int j = 0; j < 8; ++j) { v[j] = xr[64 * j]; s += (v[j].x * v[j].x + v[j].y * v[j].y) + (v[j].z * v[j].z + v[j].w * v[j].w); }
        const float rstd = 1.f / sqrtf(wave_sum(s) * (1.f / DM) + EPS);
#pragma unroll
        for (int j = 0; j < 8; ++j) { const f32x4 gg = *((const f32x4*)p.final_norm + lane + 64 * j); f32x4 o = v[j] * rstd * gg;
            xr[64 * j] = o; }
    }
}


#define XB_TMO      128
#define XB_XCNT(j)  (256  + 64 * (j))
#define XB_XSUB(j)  (1280 + 64 * (j))
#define XB_XGEN(j)  (2304 + 64 * (j))
#define XB_TOP      3328
#define XB_TOPGEN   3392
#define XCD_BAR_WORDS 3456
#define XB_SPIN_CAP (1u << 18)
__device__ __forceinline__ unsigned xb_ld(unsigned* p)              { return __hip_atomic_load(p, __ATOMIC_RELAXED, __HIP_MEMORY_SCOPE_AGENT); }
__device__ __forceinline__ unsigned xb_add(unsigned* p, unsigned v) { return __hip_atomic_fetch_add(p, v, __ATOMIC_RELAXED, __HIP_MEMORY_SCOPE_AGENT); }
__device__ __forceinline__ unsigned xb_xcc_id() { return (unsigned)__builtin_amdgcn_s_getreg((3 << 11) | 20) & 0xFu; }
#define XB_SPIN(cond, bar) do { unsigned _sp = 0; while (cond) { __builtin_amdgcn_s_sleep(1); \
    if ((++_sp & 255u) == 0u) { if (xb_ld(&(bar)[XB_TMO])) break; if (_sp > XB_SPIN_CAP) { atomicAdd(&(bar)[XB_TMO], 1u); break; } } } } while (0)
struct XcdBarrier { unsigned* bar; unsigned x; volatile LAS unsigned* st; };
__device__ __forceinline__ XcdBarrier xcd_barrier_post(unsigned* bar, volatile LAS unsigned* st) {
    XcdBarrier b; b.bar = bar; b.x = xb_xcc_id(); b.st = st;
    if (threadIdx.x == 0) (void)xb_add(&bar[XB_XCNT(b.x)], 1u);
    return b;
}
__device__ __forceinline__ void xcd_barrier_complete(unsigned* bar, unsigned x, unsigned& nloc, unsigned& nx) {
    const unsigned G = gridDim.x * gridDim.y * gridDim.z;
    unsigned sum, cnt, mine, sp = 0u;
    for (;;) {
        sum = 0u; cnt = 0u; mine = 0u;
#pragma unroll
        for (unsigned j = 0; j < 16; ++j) { const unsigned c = xb_ld(&bar[XB_XCNT(j)]); sum += c; cnt += (c > 0u) ? 1u : 0u; mine = (j == x) ? c : mine; }
        if (sum == G) break;
        __builtin_amdgcn_s_sleep(1);
        if ((++sp & 255u) == 0u) { if (xb_ld(&bar[XB_TMO])) break; if (sp > XB_SPIN_CAP) { atomicAdd(&bar[XB_TMO], 1u); break; } }
    }
    nloc = mine > 0u ? mine : 1u; nx = cnt > 0u ? cnt : 1u;
}
__device__ __forceinline__ void xcd_barrier(const XcdBarrier& b) {
    asm volatile("s_waitcnt vmcnt(0)" ::: "memory");
    __syncthreads();
    if (threadIdx.x == 0) {
        unsigned* bar = b.bar;
        __builtin_amdgcn_s_waitcnt(0);
        unsigned nloc = b.st[0], nx = b.st[1];
        if (nloc == 0u) { xcd_barrier_complete(bar, b.x, nloc, nx); b.st[0] = nloc; b.st[1] = nx; }
        const unsigned old = xb_add(&bar[XB_XSUB(b.x)], 1u);
        const unsigned gen = old / nloc;
        if (old + 1u == (gen + 1u) * nloc) {
            __builtin_amdgcn_fence(__ATOMIC_RELEASE, "agent");
            asm volatile("s_waitcnt vmcnt(0)" ::: "memory");
            const unsigned og = xb_add(&bar[XB_TOP], 1u);
            const unsigned tg = og / nx;
            if (og + 1u == (tg + 1u) * nx) xb_add(&bar[XB_TOPGEN], 1u);
            else XB_SPIN(xb_ld(&bar[XB_TOPGEN]) == tg, bar);
            __builtin_amdgcn_fence(__ATOMIC_ACQUIRE, "agent");
            xb_add(&bar[XB_XGEN(b.x)], 1u);
            asm volatile("s_waitcnt vmcnt(0)" ::: "memory");
        } else {
            XB_SPIN(xb_ld(&bar[XB_XGEN(b.x)]) == gen, bar);
            __builtin_amdgcn_fence(__ATOMIC_ACQUIRE, "agent");
            asm volatile("s_waitcnt vmcnt(0)" ::: "memory");
        }
    }
    __syncthreads();
}

__global__ void __launch_bounds__(512, 2) fwd_megakernel(Params p) {
    extern __shared__ __attribute__((aligned(16))) unsigned char smem[];
    cg::grid_group grid = cg::this_grid();
    unsigned char* ws = p.ws;
    LAS unsigned char* lds3 = (LAS unsigned char*)smem;
    const int G = gridDim.x, c = blockIdx.x;
    prep_phase(p, 0, smem, p.x, p.norm_mix);
    { volatile LAS unsigned* stz = (volatile LAS unsigned*)(lds3 + LDS_BYTES - 32); if (threadIdx.x == 0) { stz[0] = 0u; stz[1] = 0u; } }
    grid.sync();
    const XcdBarrier xb = xcd_barrier_post((unsigned*)(ws + WS_XBAR), (volatile LAS unsigned*)(lds3 + LDS_BYTES - 32));
    for (int layer = 0; layer < DEPTH; ++layer) {
        const float* xin = layer == 0 ? p.x : p.out;
        {
            pg8::Sched S; S.init(NTOK, INC, DM, G, c, 1); S.A0 = (const bf16_t*)(ws + WS_HB); S.B0 = (const bf16_t*)(ws + WS_WIN); S.zsA = 0; S.zsB = 0;
            EpiIn E; E.projA = (bf16_t*)(ws + WS_PROJA); E.gates = (bf16_t*)(ws + WS_GATES); E.ropeR = (const float*)(ws + WS_ROPER); E.ropeM = (const float*)(ws + WS_ROPEM);
            pg8::gemm_phase(lds3, S, E);
        }
        xcd_barrier(xb);
        m1_phase(p, layer, smem);
        xcd_barrier(xb);
        m2_phase(p);
        xcd_barrier(xb);
        m3_phase(p, layer, smem);
        xcd_barrier(xb);
        {
            pg8::Sched S; S.init(NTOK, DM, 1024, G, c, 3);
            S.A0 = (const bf16_t*)(ws + WS_BOUT); S.zsA = (size_t)NTOK * 1024; S.B0 = (const bf16_t*)(ws + WS_WBR); S.zsB = E_WBR;
            EpiBr E; E.gates = (const bf16_t*)(ws + WS_GATES); E.mixb = (bf16_t*)(ws + WS_MIXB);
            pg8::gemm_phase(lds3, S, E);
        }
        xcd_barrier(xb);
        {
            pg8::Sched S; S.init(NTOK, DM, DM, G, c, 1); S.A0 = (const bf16_t*)(ws + WS_MIXB); S.B0 = (const bf16_t*)(ws + WS_WOUT); S.zsA = 0; S.zsB = 0;
            EpiRes E; E.xin = xin; E.xout = p.out;
            pg8::gemm_phase(lds3, S, E);
        }
        xcd_barrier(xb);
        {
            const int tq = tid_fresh(); const int wave = tq >> 6, lane = tq & 63;
            rmsnorm_rows_bf16(p.out, p.norm_ffn + (size_t)layer * DM, (bf16_t*)(ws + WS_HB), c * 8 + wave, G * 8, lane);
        }
        xcd_barrier(xb);
        {
            pg8::Sched S; S.init(NTOK, 2 * FH, DM, G, c, 1); S.A0 = (const bf16_t*)(ws + WS_HB); S.B0 = (const bf16_t*)(ws + WS_WGU); S.zsA = 0; S.zsB = 0;
            EpiGU E; E.ffh = (bf16_t*)(ws + WS_FFH);
            pg8::gemm_phase(lds3, S, E);
        }
        xcd_barrier(xb);
        {
            pg8::Sched S; S.init(NTOK, DM, FH, G, c, 1); S.A0 = (const bf16_t*)(ws + WS_FFH); S.B0 = (const bf16_t*)(ws + WS_WDN); S.zsA = 0; S.zsB = 0;
            EpiRes E; E.xin = p.out; E.xout = p.out;
            pg8::gemm_phase(lds3, S, E);
        }
        xcd_barrier(xb);
        if (layer + 1 < DEPTH) { prep_phase(p, layer + 1, smem, p.out, p.norm_mix + (size_t)(layer + 1) * DM); xcd_barrier(xb);
        }
    }
    final_norm_phase(p);
}

extern "C" void kernel_launch(void* const* d_in, const int* in_sizes, int n_in, void* d_out, int out_size, void* d_ws, size_t ws_size, hipStream_t stream) {
    static int grid_blocks = 0;
    if (grid_blocks == 0) {
        if (n_in != 15 || out_size != NTOK * DM || ws_size < WS_END) { fprintf(stderr, "kernel_launch: unexpected shapes (n_in %d out %d ws %zu need %zu)\n", n_in, out_size, ws_size, (size_t)WS_END); grid_blocks = -1; return; }
        int dev = 0, cus = 0, per_cu = 0;
        hipGetDevice(&dev);
        hipDeviceGetAttribute(&cus, hipDeviceAttributeMultiprocessorCount, dev);
        if (hipFuncSetAttribute((const void*)fwd_megakernel, hipFuncAttributeMaxDynamicSharedMemorySize, LDS_BYTES) != hipSuccess) { fprintf(stderr, "kernel_launch: hipFuncSetAttribute failed\n"); }
        if (hipOccupancyMaxActiveBlocksPerMultiprocessor(&per_cu, (const void*)fwd_megakernel, 512, LDS_BYTES) != hipSuccess || per_cu < 1) { fprintf(stderr, "kernel_launch: occupancy query gave %d\n", per_cu); per_cu = 1; }
        (void)hipGetLastError();
        grid_blocks = cus;
        if (grid_blocks > 256) grid_blocks = 256;
    }
    if (grid_blocks < 0) return;
    Params p{};
    p.x = (const float*)d_in[0]; p.lb = (const float*)d_in[1]; p.norm_mix = (const float*)d_in[2]; p.w_in = (const float*)d_in[3]; p.ret_norm = (const float*)d_in[4]; p.hgrn_norm = (const float*)d_in[5];
    p.w_br[0] = (const float*)d_in[6]; p.w_br[1] = (const float*)d_in[7]; p.w_br[2] = (const float*)d_in[8]; p.w_out = (const float*)d_in[9]; p.norm_ffn = (const float*)d_in[10];
    p.w_gate = (const float*)d_in[11]; p.w_up = (const float*)d_in[12]; p.w_down = (const float*)d_in[13]; p.final_norm = (const float*)d_in[14];
    p.out = (float*)d_out; p.ws = (unsigned char*)d_ws;
    void* args[] = {&p};
    hipError_t e = hipLaunchCooperativeKernel((const void*)fwd_megakernel, dim3(grid_blocks), dim3(512), args, LDS_BYTES, stream);
    if (e != hipSuccess) fprintf(stderr, "cooperative launch failed: %s (grid %d)\n", hipGetErrorString(e), grid_blocks);
}
```

```cpp
#include <hip/hip_runtime.h>
#include <hip/hip_cooperative_groups.h>
#include <cstdio>
namespace cg = cooperative_groups;

#define LAS __attribute__((address_space(3)))
typedef unsigned short bf16_t;
typedef short bf16x8 __attribute__((ext_vector_type(8)));
typedef short bf16x4 __attribute__((ext_vector_type(4)));
typedef float f32x4 __attribute__((ext_vector_type(4)));
typedef unsigned u32x4 __attribute__((ext_vector_type(4)));
typedef unsigned u32x2 __attribute__((ext_vector_type(2)));

constexpr int DM = 2048, SEQ = 4096, NTOK = 16384, DEPTH = 2;
constexpr int INC = 17408, PA = 11264, GC = 6144, FH = 5632;
constexpr int C_RQ = 0, C_RK = 1024, C_RV = 2048, C_RG = 3072, C_MQ = 4096, C_MK = 5120, C_MV = 6144, C_HQ = 7168, C_HF = 8192, C_HI = 9216, C_HG = 10240;
constexpr float EPS = 1e-6f;

constexpr size_t E_WIN = (size_t)DM * INC, E_WBR = (size_t)1024 * DM, E_WOUT = (size_t)DM * DM, E_WGU = (size_t)2 * DM * FH, E_WDN = (size_t)FH * DM;
constexpr size_t WS_WIN = 0;
constexpr size_t WS_WBR = WS_WIN + E_WIN * 2;
constexpr size_t WS_WOUT = WS_WBR + 3 * E_WBR * 2;
constexpr size_t WS_WGU = WS_WOUT + E_WOUT * 2;
constexpr size_t WS_WDN = WS_WGU + E_WGU * 2;
constexpr size_t WS_HB = WS_WDN + E_WDN * 2;
constexpr size_t WS_PROJA = WS_HB + (size_t)NTOK * DM * 2;
constexpr size_t WS_MIXB = WS_PROJA;
constexpr size_t WS_MIX32 = WS_PROJA + (size_t)NTOK * DM * 2;
constexpr size_t WS_FFH = WS_MIX32;
constexpr size_t WS_GATES = WS_PROJA + (size_t)NTOK * PA * 2;
constexpr size_t WS_BOUT = WS_GATES + (size_t)NTOK * GC * 2;
constexpr size_t WS_STR = WS_BOUT + (size_t)3 * NTOK * 1024 * 2;
constexpr size_t WS_STH = WS_STR + (size_t)512 * 65536 * 2;
constexpr size_t WS_HDEC = WS_STH + (size_t)2048 * 16384 * 2;
constexpr size_t WS_KMEAN = WS_HDEC + (size_t)2048 * 128 * 4;
constexpr size_t WS_ROPER = WS_KMEAN + (size_t)512 * 128 * 4;
constexpr size_t WS_ROPEM = WS_ROPER + (size_t)2 * 4096 * 128 * 4;
constexpr size_t WS_CTR = WS_ROPEM + (size_t)2 * 4096 * 16 * 4;
constexpr size_t WS_XBAR = WS_CTR + 256;
constexpr size_t WS_END = WS_XBAR + 3456 * 4;

constexpr int LDS_BYTES = 160 * 1024;
constexpr int LDS_ITEM_OFF = LDS_BYTES - 16;

struct Params {
    const float* x; const float* lb; const float* norm_mix; const float* w_in; const float* ret_norm; const float* hgrn_norm;
    const float* w_br[3]; const float* w_out; const float* norm_ffn; const float* w_gate; const float* w_up; const float* w_down; const float* final_norm;
    float* out; unsigned char* ws;
};

typedef __bf16 bf16v2_t __attribute__((ext_vector_type(2)));
typedef float f32x2_t __attribute__((ext_vector_type(2)));
__device__ __forceinline__ unsigned cvt_pk_bf16(float lo, float hi) { const f32x2_t v = {lo, hi}; const bf16v2_t b = __builtin_convertvector(v, bf16v2_t); return __builtin_bit_cast(unsigned, b); }
__device__ __forceinline__ float bf2f(unsigned short b) { return __uint_as_float(((unsigned)b) << 16); }
__device__ __forceinline__ float bflo(unsigned w) { return __uint_as_float(w << 16); }
__device__ __forceinline__ float bfhi(unsigned w) { return __uint_as_float(w & 0xffff0000u); }
__device__ __forceinline__ float frcp_(float x) { return __builtin_amdgcn_rcpf(x); }
__device__ __forceinline__ float sigmoidf_(float v) { return frcp_(1.f + __expf(-v)); }
__device__ __forceinline__ float siluf_(float v) { return v * frcp_(1.f + __expf(-v)); }
__device__ __forceinline__ int tid_fresh() { int t = threadIdx.x; asm volatile("" : "+v"(t)); return t; }
__device__ __forceinline__ float wave_sum(float v) {
#pragma unroll
    for (int o = 1; o < 64; o <<= 1) v += __shfl_xor(v, o);
    return v;
}

namespace pg8 {
constexpr int BM = 256, BK = 64, HALF = 128, HTB = HALF * BK * 2, STAGE_BYTES = 8 * HTB, NXCD = 8, WGM = 8;
__host__ __device__ __forceinline__ int lds_byte(int r, int c) { const int st = (r >> 4) * 2 + (c >> 5), rr = r & 15, cc = c & 31, ob = rr * 64 + cc * 2; return st * 1024 + (ob ^ (((ob >> 9) & 1) << 5)); }
__host__ __device__ __forceinline__ void stage_rc(int b, int& R, int& C) { const int st = b / 1024, sb = b % 1024, swz = sb ^ (((sb >> 9) & 1) << 5); R = (st >> 1) * 16 + swz / 64; C = (st & 1) * 32 + (swz % 64) / 2; }
__host__ __device__ __forceinline__ int perm32(int rho) { const int n = rho >> 4, i = rho & 15; return 8 * (i >> 2) + 4 * n + (i & 3); }

struct Unit { int pm, pn, z; };
struct Sched {
    int nM, nN, nwg, G, c, nz, K;
    const bf16_t* A0; const bf16_t* B0; size_t zsA, zsB;
    __device__ void init(int M, int N, int K_, int G_, int c_, int nz_) { nM = M / BM; nN = N / BM; nwg = nM * nN; G = G_; c = c_; nz = nz_; K = K_; }
    __device__ bool next(int i, Unit& u) const {
        const int r = i / nz; u.z = i - r * nz;
        const long L = (long)r * G + c; if (L >= nwg) return false;
        int wgid = (int)L; { const int q = nwg / NXCD, rr = nwg % NXCD, xcd = wgid % NXCD, off = wgid / NXCD; wgid = (xcd < rr ? xcd * (q + 1) : rr * (q + 1) + (xcd - rr) * q) + off; }
        const int nig = WGM * nN, gid = wgid / nig, fm = gid * WGM, gsz = (nM - fm) < WGM ? (nM - fm) : WGM;
        u.pm = fm + ((wgid % nig) % gsz); u.pn = (wgid % nig) / gsz; return true;
    }
    __device__ __forceinline__ const char* baseA(const Unit& u) const { return (const char*)(A0 + (size_t)u.z * zsA) + (size_t)u.pm * (size_t)BM * K * 2; }
    __device__ __forceinline__ const char* baseB(const Unit& u) const { return (const char*)(B0 + (size_t)u.z * zsB) + (size_t)u.pn * (size_t)BM * K * 2; }
};

template <class Epi>
__device__ __forceinline__ void gemm_phase(LAS unsigned char* lds, const Sched& S, const Epi& E) {
    const int tid = tid_fresh(), wid = __builtin_amdgcn_readfirstlane(tid >> 6), lane = tid & 63, wr = wid >> 2, wc = wid & 3, fr = lane & 15, fq = lane >> 4;
    const int K = S.K, nt = K / BK;
    unsigned voffA[2], voffB[2];
#pragma unroll
    for (int i = 0; i < 2; ++i) { int R, C; stage_rc(tid * 16 + i * 8192, R, C); const int Rb = Epi::PERM ? ((R & ~31) + perm32(R & 31)) : R;
        voffA[i] = (unsigned)(R * K + C) * 2u; voffB[i] = (unsigned)(Rb * K + C) * 2u; }
    const size_t kstep = (size_t)(BK * 2);
    const size_t hstep = (size_t)HALF * K * 2;
    const unsigned ldsw = (unsigned)wid * 1024u;
    const int aoff = lds_byte(wr * 64 + fr, fq * 8), boff = lds_byte(wc * 32 + fr, fq * 8);
#define PG8_SA(b, h) (((b) * 2 + (h)) * HTB)
#define PG8_SB(b, h) ((4 + (b) * 2 + (h)) * HTB)
#define PG8_STAGE(bufoff, gbase, voff) do { _Pragma("unroll") for (int _i = 0; _i < 2; ++_i) \
        __builtin_amdgcn_global_load_lds((const unsigned*)((const char*)(gbase) + (voff)[_i]), (LAS unsigned*)(lds + (bufoff) + ldsw + _i * 8192), 16, 0, 0); } while (0)
#define PG8_LDA(dst, b, h) do { _Pragma("unroll") for (int m = 0; m < 4; ++m) _Pragma("unroll") for (int k = 0; k < 2; ++k) dst[m][k] = *(const LAS bf16x8*)(lds + PG8_SA(b, h) + aoff + m * 2048 + k * 1024); } while (0)
#define PG8_LDB(dst, b, h) do { _Pragma("unroll") for (int n = 0; n < 2; ++n) _Pragma("unroll") for (int k = 0; k < 2; ++k) dst[n][k] = *(const LAS bf16x8*)(lds + PG8_SB(b, h) + boff + n * 2048 + k * 1024); } while (0)
#define PG8_MMA(ai, bj, At, Bt) do { __builtin_amdgcn_s_setprio(1); _Pragma("unroll") for (int m = 0; m < 4; ++m) _Pragma("unroll") for (int n = 0; n < 2; ++n) _Pragma("unroll") for (int k = 0; k < 2; ++k) \
        acc[ai][bj][m][n] = __builtin_amdgcn_mfma_f32_16x16x32_bf16(Bt[n][k], At[m][k], acc[ai][bj][m][n], 0, 0, 0); __builtin_amdgcn_s_setprio(0); } while (0)
#define PG8_WAIT_V(n) asm volatile("s_waitcnt vmcnt(" #n ")" ::: "memory")
#define PG8_WAIT_L(n) asm volatile("s_waitcnt lgkmcnt(" #n ")" ::: "memory")
#define PG8_BAR __builtin_amdgcn_s_barrier()
#define PG8_SCHED __builtin_amdgcn_sched_barrier(0)
    Unit cur, nxt; int ui = 0;
    if (!S.next(0, cur)) return;
    f32x4 acc[2][2][4][2];
#pragma unroll
    for (int a = 0; a < 2; ++a)
#pragma unroll
        for (int b = 0; b < 2; ++b)
#pragma unroll
            for (int m = 0; m < 4; ++m)
#pragma unroll
                for (int n = 0; n < 2; ++n) acc[a][b][m][n] = (f32x4){0.f, 0.f, 0.f, 0.f};
    bf16x8 At[4][2], B0[2][2], B1[2][2];
    const char* cA = S.baseA(cur); const char* cB = S.baseB(cur);
    PG8_STAGE(PG8_SB(0, 0), cB, voffB); PG8_STAGE(PG8_SB(0, 1), cB + hstep, voffB); PG8_STAGE(PG8_SA(0, 0), cA, voffA); PG8_STAGE(PG8_SA(0, 1), cA + hstep, voffA);
    if (wr == 1) PG8_BAR;
    PG8_WAIT_V(2); PG8_BAR;
    PG8_STAGE(PG8_SB(1, 0), cB + kstep, voffB); PG8_STAGE(PG8_SA(1, 0), cA + kstep, voffA); PG8_STAGE(PG8_SB(1, 1), cB + hstep + kstep, voffB);
    PG8_WAIT_V(6); PG8_BAR;
    for (;;) {
        const bool has_next = S.next(ui + 1, nxt);
        const char* nA = has_next ? S.baseA(nxt) : cA; const char* nB = has_next ? S.baseB(nxt) : cB;
        for (int t = 0; t < nt; t += 2) {
            const bool last = (t == nt - 2);
            const char* a1 = cA + (size_t)(t + 1) * kstep;
            const char* a2 = last ? nA : cA + (size_t)(t + 2) * kstep; const char* b2 = last ? nB : cB + (size_t)(t + 2) * kstep;
            const char* a3 = a2 + kstep; const char* b3 = b2 + kstep;
            PG8_LDB(B0, 0, 0); PG8_LDB(B1, 0, 1); PG8_SCHED; PG8_LDA(At, 0, 0); PG8_STAGE(PG8_SA(1, 1), a1 + hstep, voffA);
            PG8_WAIT_V(8); PG8_WAIT_L(0); PG8_BAR; PG8_MMA(0, 0, At, B0); PG8_MMA(0, 1, At, B1); PG8_BAR; PG8_SCHED;
            PG8_LDA(At, 0, 1); PG8_STAGE(PG8_SB(0, 0), b2, voffB); PG8_STAGE(PG8_SB(0, 1), b2 + hstep, voffB); PG8_STAGE(PG8_SA(0, 0), a2, voffA);
            PG8_WAIT_V(8); PG8_WAIT_L(0); PG8_BAR; PG8_MMA(1, 0, At, B0); PG8_MMA(1, 1, At, B1); PG8_BAR; PG8_SCHED;
            PG8_LDB(B0, 1, 0); PG8_LDB(B1, 1, 1); PG8_SCHED; PG8_LDA(At, 1, 0); PG8_STAGE(PG8_SA(0, 1), a2 + hstep, voffA);
            PG8_WAIT_V(8); PG8_WAIT_L(0); PG8_BAR; PG8_MMA(0, 0, At, B0); PG8_MMA(0, 1, At, B1); PG8_BAR; PG8_SCHED;
            PG8_LDA(At, 1, 1); PG8_STAGE(PG8_SB(1, 0), b3, voffB); PG8_STAGE(PG8_SB(1, 1), b3 + hstep, voffB); PG8_STAGE(PG8_SA(1, 0), a3, voffA);
            PG8_WAIT_V(8); PG8_WAIT_L(0); PG8_BAR; PG8_MMA(1, 0, At, B0); PG8_MMA(1, 1, At, B1); PG8_BAR; PG8_SCHED;
        }
        if (wr == 0) PG8_BAR;
        bool keep = false;
        if constexpr (Epi::ZACC) { if (cur.z + 1 < S.nz) { E.mid(acc, cur, wr, wc, fr, fq); keep = true; } }
        if (!keep) E(acc, cur, wr, wc, fr, fq);
        if (!has_next) break;
        if (!keep)
        {
#pragma unroll
        for (int a = 0; a < 2; ++a)
#pragma unroll
            for (int b = 0; b < 2; ++b)
#pragma unroll
                for (int m = 0; m < 4; ++m)
#pragma unroll
                    for (int n = 0; n < 2; ++n) acc[a][b][m][n] = (f32x4){0.f, 0.f, 0.f, 0.f};
        }
        cur = nxt; cA = nA; cB = nB; ++ui;
        if (wr == 1) PG8_BAR;
    }
    PG8_WAIT_V(0);
    PG8_BAR;
#undef PG8_SA
#undef PG8_SB
#undef PG8_STAGE
#undef PG8_LDA
#undef PG8_LDB
#undef PG8_MMA
#undef PG8_WAIT_V
#undef PG8_WAIT_L
#undef PG8_BAR
#undef PG8_SCHED
}
}
using pg8::Unit;
typedef f32x4 AccT[2][2][4][2];

struct EpiIn {
    static constexpr bool PERM = true; static constexpr bool ZACC = false;
    bf16_t* projA; bf16_t* gates; const float* ropeR; const float* ropeM;
    __device__ __forceinline__ void operator()(AccT& acc, const Unit& u, int wr, int wc, int fr, int fq) const {
        const int pn = u.pn;
        const int row0 = u.pm * 256 + wr * 64 + fr;
        bf16_t* base; int ld, colt;
        if (pn < 44) { base = projA; ld = PA; colt = pn * 256; } else { base = gates; ld = GC; colt = (pn - 44) * 256; }
        const int col0 = colt + wc * 32 + 8 * fq;
        const int kind = pn < 8 ? 1 : ((pn >= 16 && pn < 24 && wc == 0) ? 2 : 0);
        const float* rt = kind == 1 ? ropeR : ropeM; const int rld = kind == 1 ? 128 : 16;
        const int i0 = kind == 1 ? wc * 32 + 8 * fq : 8 * (fq & 1);
        const float sc = (kind == 1 && pn >= 4) ? 0.0625f : 1.f;
        f32x4 cc[2], ss[2], cn[2], sn[2];
#pragma unroll
        for (int n = 0; n < 2; ++n) { cc[n] = ss[n] = cn[n] = sn[n] = (f32x4){0.f, 0.f, 0.f, 0.f}; }
        if (kind) { const int pos = row0 & (SEQ - 1);
#pragma unroll
            for (int n = 0; n < 2; ++n) { cc[n] = *(const f32x4*)(rt + (size_t)pos * rld + i0 + 4 * n); ss[n] = *(const f32x4*)(rt + (size_t)(SEQ + pos) * rld + i0 + 4 * n); } }
#pragma unroll
        for (int g = 0; g < 8; ++g) {
            const int ai = g >> 2, m = g & 3, row = row0 + ai * 128 + m * 16;
            if (kind && g < 7) { const int pos2 = (row0 + ((g + 1) >> 2) * 128 + ((g + 1) & 3) * 16) & (SEQ - 1);
#pragma unroll
                for (int n = 0; n < 2; ++n) { cn[n] = *(const f32x4*)(rt + (size_t)pos2 * rld + i0 + 4 * n); sn[n] = *(const f32x4*)(rt + (size_t)(SEQ + pos2) * rld + i0 + 4 * n); } }
            f32x4 v[2][2];
#pragma unroll
            for (int bj = 0; bj < 2; ++bj)
#pragma unroll
                for (int n = 0; n < 2; ++n) v[bj][n] = acc[ai][bj][m][n];
            if (kind == 1) {
#pragma unroll
                for (int n = 0; n < 2; ++n) { const f32x4 x1 = v[0][n], x2 = v[1][n];
                    v[0][n] = (x1 * cc[n] - x2 * ss[n]) * sc; v[1][n] = (x2 * cc[n] + x1 * ss[n]) * sc; }
            } else if (kind == 2) {
#pragma unroll
                for (int n = 0; n < 2; ++n) { const f32x4 sg = fq < 2 ? -ss[n] : ss[n];
#pragma unroll
                    for (int bj = 0; bj < 2; ++bj) { f32x4 p;
#pragma unroll
                        for (int j = 0; j < 4; ++j) p[j] = __shfl_xor(v[bj][n][j], 32);
                        v[bj][n] = v[bj][n] * cc[n] + p * sg; } }
            }
            bf16_t* rowp = base + (size_t)row * ld + col0;
#pragma unroll
            for (int bj = 0; bj < 2; ++bj) {
                u32x4 w; w.x = cvt_pk_bf16(v[bj][0][0], v[bj][0][1]); w.y = cvt_pk_bf16(v[bj][0][2], v[bj][0][3]); w.z = cvt_pk_bf16(v[bj][1][0], v[bj][1][1]); w.w = cvt_pk_bf16(v[bj][1][2], v[bj][1][3]);
                *(u32x4*)(rowp + bj * 128) = w;
            }
#pragma unroll
            for (int n = 0; n < 2; ++n) { cc[n] = cn[n]; ss[n] = sn[n]; }
        }
    }
};
struct EpiBr {
    static constexpr bool PERM = false; static constexpr bool ZACC = true;
    const bf16_t* gates; bf16_t* mixb;
    __device__ __forceinline__ void mid(AccT& acc, const Unit& u, int wr, int wc, int fr, int fq) const {
        const int row0 = u.pm * 256 + wr * 64 + fr, col0 = u.pn * 256 + wc * 32 + 4 * fq, z = u.z;
        u32x2 ac[2][2], bc[2][2], an[2][2], bn[2][2];
#pragma unroll
        for (int bj = 0; bj < 2; ++bj)
#pragma unroll
            for (int n = 0; n < 2; ++n) { const bf16_t* gp = gates + (size_t)row0 * GC + z * DM + col0 + bj * 128 + n * 16; ac[bj][n] = *(const u32x2*)gp; bc[bj][n] = *(const u32x2*)(gp + DM); }
#pragma unroll
        for (int g = 0; g < 8; ++g) {
            const int ai = g >> 2, m = g & 3;
            if (g < 7) { const int row2 = row0 + ((g + 1) >> 2) * 128 + ((g + 1) & 3) * 16;
#pragma unroll
                for (int bj = 0; bj < 2; ++bj)
#pragma unroll
                    for (int n = 0; n < 2; ++n) { const bf16_t* gp = gates + (size_t)row2 * GC + z * DM + col0 + bj * 128 + n * 16; an[bj][n] = *(const u32x2*)gp; bn[bj][n] = *(const u32x2*)(gp + DM); } }
#pragma unroll
            for (int bj = 0; bj < 2; ++bj)
#pragma unroll
                for (int n = 0; n < 2; ++n) {
                    const u32x2 ga = ac[bj][n], gb = bc[bj][n];
                    f32x4 v = acc[ai][bj][m][n];
                    v[0] *= (1.f + __expf(fminf(-bflo(gb.x), 80.f))) * frcp_(1.f + __expf(fminf(-bflo(ga.x), 80.f)));
                    v[1] *= (1.f + __expf(fminf(-bfhi(gb.x), 80.f))) * frcp_(1.f + __expf(fminf(-bfhi(ga.x), 80.f)));
                    v[2] *= (1.f + __expf(fminf(-bflo(gb.y), 80.f))) * frcp_(1.f + __expf(fminf(-bflo(ga.y), 80.f)));
                    v[3] *= (1.f + __expf(fminf(-bfhi(gb.y), 80.f))) * frcp_(1.f + __expf(fminf(-bfhi(ga.y), 80.f)));
                    acc[ai][bj][m][n] = v;
                }
#pragma unroll
            for (int bj = 0; bj < 2; ++bj)
#pragma unroll
                for (int n = 0; n < 2; ++n) { ac[bj][n] = an[bj][n]; bc[bj][n] = bn[bj][n]; }
        }
    }
    __device__ __forceinline__ void operator()(AccT& acc, const Unit& u, int wr, int wc, int fr, int fq) const {
        const int row0 = u.pm * 256 + wr * 64 + fr, col0 = u.pn * 256 + wc * 32 + 4 * fq, z = u.z;
        u32x2 gc[2][2], gn[2][2];
#pragma unroll
        for (int bj = 0; bj < 2; ++bj)
#pragma unroll
            for (int n = 0; n < 2; ++n) gc[bj][n] = *(const u32x2*)(gates + (size_t)row0 * GC + z * DM + col0 + bj * 128 + n * 16);
#pragma unroll
        for (int g = 0; g < 8; ++g) {
            const int ai = g >> 2, m = g & 3, row = row0 + ai * 128 + m * 16;
            if (g < 7) { const int row2 = row0 + ((g + 1) >> 2) * 128 + ((g + 1) & 3) * 16;
#pragma unroll
                for (int bj = 0; bj < 2; ++bj)
#pragma unroll
                    for (int n = 0; n < 2; ++n) gn[bj][n] = *(const u32x2*)(gates + (size_t)row2 * GC + z * DM + col0 + bj * 128 + n * 16); }
#pragma unroll
            for (int bj = 0; bj < 2; ++bj)
#pragma unroll
                for (int n = 0; n < 2; ++n) {
                    const int col = col0 + bj * 128 + n * 16;
                    const u32x2 gg = gc[bj][n];
                    const f32x4 v = acc[ai][bj][m][n];
                    u32x2 w; w.x = cvt_pk_bf16(v[0] * sigmoidf_(bflo(gg.x)), v[1] * sigmoidf_(bfhi(gg.x))); w.y = cvt_pk_bf16(v[2] * sigmoidf_(bflo(gg.y)), v[3] * sigmoidf_(bfhi(gg.y)));
                    *(u32x2*)(mixb + (size_t)row * DM + col) = w;
                }
#pragma unroll
            for (int bj = 0; bj < 2; ++bj)
#pragma unroll
                for (int n = 0; n < 2; ++n) gc[bj][n] = gn[bj][n];
        }
    }
};
struct EpiRes {
    static constexpr bool PERM = false; static constexpr bool ZACC = false;
    const float* xin; float* xout;
    __device__ __forceinline__ void operator()(AccT& acc, const Unit& u, int wr, int wc, int fr, int fq) const {
        const int row0 = u.pm * 256 + wr * 64 + fr, col0 = u.pn * 256 + wc * 32 + 4 * fq;
        f32x4 cur[2][2], nxt[2][2];
        { const size_t ro = (size_t)row0 * DM + col0;
#pragma unroll
          for (int bj = 0; bj < 2; ++bj)
#pragma unroll
              for (int n = 0; n < 2; ++n) cur[bj][n] = *(const f32x4*)(xin + ro + bj * 128 + n * 16); }
#pragma unroll
        for (int g = 0; g < 8; ++g) {
            const int ai = g >> 2, m = g & 3;
            if (g < 7) { const int ai2 = (g + 1) >> 2, m2 = (g + 1) & 3; const size_t ro2 = (size_t)(row0 + ai2 * 128 + m2 * 16) * DM + col0;
#pragma unroll
                for (int bj = 0; bj < 2; ++bj)
#pragma unroll
                    for (int n = 0; n < 2; ++n) nxt[bj][n] = *(const f32x4*)(xin + ro2 + bj * 128 + n * 16); }
            const size_t ro = (size_t)(row0 + ai * 128 + m * 16) * DM + col0;
#pragma unroll
            for (int bj = 0; bj < 2; ++bj)
#pragma unroll
                for (int n = 0; n < 2; ++n) *(f32x4*)(xout + ro + bj * 128 + n * 16) = acc[ai][bj][m][n] + cur[bj][n];
#pragma unroll
            for (int bj = 0; bj < 2; ++bj)
#pragma unroll
                for (int n = 0; n < 2; ++n) cur[bj][n] = nxt[bj][n];
        }
    }
};
struct EpiGU {
    static constexpr bool PERM = true; static constexpr bool ZACC = false;
    bf16_t* ffh;
    __device__ __forceinline__ void operator()(AccT& acc, const Unit& u, int wr, int wc, int fr, int fq) const {
        const int row0 = u.pm * 256 + wr * 64 + fr, col0 = u.pn * 128 + wc * 32 + 8 * fq;
#pragma unroll
        for (int ai = 0; ai < 2; ++ai)
#pragma unroll
            for (int m = 0; m < 4; ++m) {
                f32x4 h0 = acc[ai][0][m][0], h1 = acc[ai][0][m][1]; const f32x4 u0 = acc[ai][1][m][0], u1 = acc[ai][1][m][1];
#pragma unroll
                for (int j = 0; j < 4; ++j) { h0[j] = siluf_(h0[j]) * u0[j]; h1[j] = siluf_(h1[j]) * u1[j]; }
                u32x4 w; w.x = cvt_pk_bf16(h0[0], h0[1]); w.y = cvt_pk_bf16(h0[2], h0[3]); w.z = cvt_pk_bf16(h1[0], h1[1]); w.w = cvt_pk_bf16(h1[2], h1[3]);
                *(u32x4*)(ffh + (size_t)(row0 + ai * 128 + m * 16) * FH + col0) = w;
            }
    }
};

__device__ __forceinline__ void transpose_item(const float* W, int K, int N, bf16_t* WT, int grp_shift, int gmul, int goff, float* scr, int item, int lane) {
    const int nblk = N / 32, kb = item / nblk, nb = item - kb * nblk, k0 = 64 * kb, n0 = 32 * nb;
    float wv[32];
    { const float* wp = W + (size_t)(k0 + (lane >> 5)) * N + n0 + (lane & 31);
#pragma unroll
      for (int i = 0; i < 32; ++i) wv[i] = __builtin_nontemporal_load(wp + (size_t)(2 * i) * N); }
#pragma unroll
    for (int i = 0; i < 32; ++i) scr[(2 * i + (lane >> 5)) * 33 + (lane & 31)] = wv[i];
    __builtin_amdgcn_wave_barrier();
    const int c = lane & 7;
#pragma unroll
    for (int j = 0; j < 4; ++j) { const int n = (lane >> 3) + 8 * j; const float* s = scr + (8 * c) * 33 + n;
        u32x4 o; o.x = cvt_pk_bf16(s[0 * 33], s[1 * 33]); o.y = cvt_pk_bf16(s[2 * 33], s[3 * 33]); o.z = cvt_pk_bf16(s[4 * 33], s[5 * 33]); o.w = cvt_pk_bf16(s[6 * 33], s[7 * 33]);
        const int ng = n0 + n; const int drow = grp_shift >= 0 ? (((ng >> grp_shift) * gmul) + goff + (ng & ((1 << grp_shift) - 1))) : ng;
        *(u32x4*)(WT + (size_t)drow * K + k0 + 8 * c) = o; }
    __builtin_amdgcn_wave_barrier();
}

__device__ __forceinline__ void rmsnorm_rows_bf16(const float* x, const float* g, bf16_t* o, int gw, int ngw, int lane) {
    for (int r = gw; r < NTOK; r += 2 * ngw) {
        const int r2 = r + ngw;
        const f32x4* xa = (const f32x4*)(x + (size_t)r * DM) + lane; const f32x4* xb = (const f32x4*)(x + (size_t)r2 * DM) + lane;
        f32x4 va[8], vb[8]; float sa = 0.f, sb = 0.f;
#pragma unroll
        for (int j = 0; j < 8; ++j) { va[j] = xa[64 * j]; vb[j] = xb[64 * j]; }
#pragma unroll
        for (int j = 0; j < 8; ++j) { sa += (va[j].x * va[j].x + va[j].y * va[j].y) + (va[j].z * va[j].z + va[j].w * va[j].w); sb += (vb[j].x * vb[j].x + vb[j].y * vb[j].y) + (vb[j].z * vb[j].z + vb[j].w * vb[j].w); }
#pragma unroll
        for (int o2 = 1; o2 < 64; o2 <<= 1) { sa += __shfl_xor(sa, o2); sb += __shfl_xor(sb, o2); }
        const float ra = 1.f / sqrtf(sa * (1.f / DM) + EPS), rb = 1.f / sqrtf(sb * (1.f / DM) + EPS);
        u32x2* oa = (u32x2*)(o + (size_t)r * DM) + lane; u32x2* ob = (u32x2*)(o + (size_t)r2 * DM) + lane;
#pragma unroll
        for (int j = 0; j < 8; ++j) { const f32x4 gg = *((const f32x4*)g + lane + 64 * j);
            u32x2 w; w.x = cvt_pk_bf16(va[j].x * ra * gg.x, va[j].y * ra * gg.y); w.y = cvt_pk_bf16(va[j].z * ra * gg.z, va[j].w * ra * gg.w); oa[64 * j] = w;
            u32x2 w2; w2.x = cvt_pk_bf16(vb[j].x * rb * gg.x, vb[j].y * rb * gg.y); w2.y = cvt_pk_bf16(vb[j].z * rb * gg.z, vb[j].w * rb * gg.w); ob[64 * j] = w2; }
    }
}

__device__ __forceinline__ void rope_entry(double base_log2, int rot, int i, int pos, float& co, float& si) {
    const double inv = exp2(-(2.0 * i / rot) * base_log2);
    const double ang = (double)pos * inv;
    const double TWO_PI = 6.283185307179586476925286766559;
    const double k = rint(ang / TWO_PI);
    const double r = fma(-k, 2.4492935982947064e-16, fma(-k, TWO_PI, ang));
    const double r2 = r * r;
    double ts = r, ss = r, tc = 1.0, sc = 1.0;
#pragma unroll
    for (int n = 1; n <= 14; ++n) { ts *= -r2 / (double)((2 * n) * (2 * n + 1)); ss += ts; tc *= -r2 / (double)((2 * n - 1) * (2 * n)); sc += tc; }
    co = (float)sc; si = (float)ss;
}

__device__ __forceinline__ void prep_phase(const Params& p, int layer, unsigned char* lds, const float* xin, const float* gain) {
    const int tid = tid_fresh(), wave = tid >> 6, lane = tid & 63;
    const int G = gridDim.x, gw = blockIdx.x * 8 + wave, ngw = G * 8;
    float* scr = (float*)(lds + wave * 16384);
    unsigned char* ws = p.ws;
    if (layer == 0) {
        if (blockIdx.x == 0) { if (tid < 64) ((unsigned*)(ws + WS_CTR))[tid] = 0u; for (int e = tid; e < 3456; e += 512) ((unsigned*)(ws + WS_XBAR))[e] = 0u; }
        float* rr = (float*)(ws + WS_ROPER); float* rm = (float*)(ws + WS_ROPEM);
        const int gt = blockIdx.x * 512 + tid, ngt = G * 512;
        for (int e = gt; e < SEQ * 128; e += ngt) { const int pos = e >> 7, i = e & 127; float c, s; rope_entry(13.287712379549449, 256, i, pos, c, s); rr[e] = c; rr[SEQ * 128 + e] = s; }
        for (int e = gt; e < SEQ * 16; e += ngt) { const int pos = e >> 4, i = e & 15; float c, s; rope_entry(18.931568569324174, 32, i, pos, c, s); rm[e] = c; rm[SEQ * 16 + e] = s; }
    }
    constexpr int I_IN = (DM / 64) * (INC / 32), I_BR = (1024 / 64) * (DM / 32), I_OUT = (DM / 64) * (DM / 32), I_G = (DM / 64) * (FH / 32), I_DN = (FH / 64) * (DM / 32);
    constexpr int NITEMS = I_IN + 3 * I_BR + I_OUT + 2 * I_G + I_DN;
    for (int it = gw; it < NITEMS; it += ngw) {
        int r = it;
        if (r < I_IN) { transpose_item(p.w_in + (size_t)layer * E_WIN, DM, INC, (bf16_t*)(ws + WS_WIN), -1, 0, 0, scr, r, lane); continue; } r -= I_IN;
        if (r < 3 * I_BR) { const int b = r / I_BR; transpose_item(p.w_br[b] + (size_t)layer * E_WBR, 1024, DM, (bf16_t*)(ws + WS_WBR) + (size_t)b * E_WBR, -1, 0, 0, scr, r - b * I_BR, lane); continue; } r -= 3 * I_BR;
        if (r < I_OUT) { transpose_item(p.w_out + (size_t)layer * E_WOUT, DM, DM, (bf16_t*)(ws + WS_WOUT), -1, 0, 0, scr, r, lane); continue; } r -= I_OUT;
        if (r < I_G) { transpose_item(p.w_gate + (size_t)layer * DM * FH, DM, FH, (bf16_t*)(ws + WS_WGU), 7, 256, 0, scr, r, lane); continue; } r -= I_G;
        if (r < I_G) { transpose_item(p.w_up + (size_t)layer * DM * FH, DM, FH, (bf16_t*)(ws + WS_WGU), 7, 256, 128, scr, r, lane); continue; } r -= I_G;
        transpose_item(p.w_down + (size_t)layer * E_WDN, FH, DM, (bf16_t*)(ws + WS_WDN), -1, 0, 0, scr, r, lane);
    }
    rmsnorm_rows_bf16(xin, gain, (bf16_t*)(ws + WS_HB), gw, ngw, lane);
}

template <bool SWAP>
__device__ __forceinline__ f32x4 mma_tile(const bf16_t* A, int lda, const bf16_t* B, int ldb, int ksteps, f32x4 acc, int lane) {
    const bf16_t* ap = A + (lane & 15) * lda + (lane >> 4) * 8;
    const bf16_t* bp = B + (lane & 15) * ldb + (lane >> 4) * 8;
    for (int ks = 0; ks < ksteps; ++ks) {
        const bf16x8 a = *(const bf16x8*)(ap + ks * 32), b = *(const bf16x8*)(bp + ks * 32);
        acc = SWAP ? __builtin_amdgcn_mfma_f32_16x16x32_bf16(b, a, acc, 0, 0, 0) : __builtin_amdgcn_mfma_f32_16x16x32_bf16(a, b, acc, 0, 0, 0);
    }
    return acc;
}
__device__ __forceinline__ void stage_copy(const bf16_t* src, int ld, int nrows, int ncols, bf16_t* dst, int lds_ld, int tid) {
    const int cgs = ncols >> 3, total = nrows * cgs;
    for (int idx = tid; idx < total; idx += 512) { const int r = idx / cgs, c = idx - r * cgs;
        *(u32x4*)(dst + r * lds_ld + c * 8) = *(const u32x4*)(src + (size_t)r * ld + c * 8); }
}
template <class F>
__device__ __forceinline__ void stage_T(const bf16_t* src, int ld, int nrows, int ncols, bf16_t* dst, int lds_ld, int tid, F f) {
    const int cgs = ncols >> 3, total = (nrows >> 1) * cgs;
    for (int idx = tid; idx < total; idx += 512) { const int rp = idx / cgs, c = idx - rp * cgs;
        const u32x4 a = *(const u32x4*)(src + (size_t)(2 * rp) * ld + c * 8), b = *(const u32x4*)(src + (size_t)(2 * rp + 1) * ld + c * 8);
        const unsigned aw[4] = {a.x, a.y, a.z, a.w}, bw[4] = {b.x, b.y, b.z, b.w};
#pragma unroll
        for (int i = 0; i < 4; ++i) {
            const int cc = c * 8 + 2 * i;
            *(unsigned*)(dst + (cc) * lds_ld + 2 * rp) = cvt_pk_bf16(f(bflo(aw[i]), 2 * rp, cc), f(bflo(bw[i]), 2 * rp + 1, cc));
            *(unsigned*)(dst + (cc + 1) * lds_ld + 2 * rp) = cvt_pk_bf16(f(bfhi(aw[i]), 2 * rp, cc + 1), f(bfhi(bw[i]), 2 * rp + 1, cc + 1));
        }
    }
}
__device__ __forceinline__ float ret_log2_gamma(int h) { return log2f(1.f - exp2f(-5.f - (float)h)); }
__device__ __forceinline__ float hgrn_lower(const float* lb, int layer, int c) {
    if (layer == 0) return 0.f;
    return 1.f / (1.f + __expf(lb[c] - lb[1024 + c]));
}

typedef short s16x4 __attribute__((ext_vector_type(4)));
__device__ __forceinline__ bf16x8 tr_frag_perm(LAS unsigned char* base, int row0, int col0, int ld, int fr, int fq) {
    const int off = ((row0 + fq * 4 + (fr >> 2)) * ld + col0 + (fr & 3) * 4) * 2;
    const s16x4 lo = __builtin_amdgcn_ds_read_tr16_b64_v4i16((LAS s16x4*)(base + off));
    const s16x4 hi = __builtin_amdgcn_ds_read_tr16_b64_v4i16((LAS s16x4*)(base + off + 16 * ld * 2));
    return __builtin_shufflevector(lo, hi, 0, 1, 2, 3, 4, 5, 6, 7);
}
__device__ __forceinline__ bf16x8 row_frag_perm(const bf16_t* M, int ld, int r0, int k0, int fr, int fq) {
    const bf16_t* q = M + (r0 + fr) * ld + k0 + fq * 4;
    const u32x2 lo = *(const u32x2*)q, hi = *(const u32x2*)(q + 16);
    u32x4 w; w.x = lo.x; w.y = lo.y; w.z = hi.x; w.w = hi.y; return __builtin_bit_cast(bf16x8, w);
}
__device__ __forceinline__ void m1_ret(const Params& p, unsigned char* lds, int item) {
    const int tid = tid_fresh(), wave = tid >> 6, lane = tid & 63, fr = lane & 15, fq = lane >> 4;
    const int bh = item >> 5, n = item & 31, b = bh >> 2, h = bh & 3;
    const bf16_t* projA = (const bf16_t*)(p.ws + WS_PROJA);
    const size_t t0 = (size_t)b * SEQ + n * 128;
    bf16_t* Vs = (bf16_t*)lds; bf16_t* Ks = (bf16_t*)(lds + 128 * 272 * 2);
    const float l2g = ret_log2_gamma(h);
    {
        const int r0 = tid >> 5, c0 = tid & 31;
        u32x4 vv[8], kv[8];
#pragma unroll
        for (int i = 0; i < 8; ++i) { vv[i] = *(const u32x4*)(projA + (t0 + r0 + 16 * i) * PA + C_RV + h * 256 + c0 * 8); kv[i] = *(const u32x4*)(projA + (t0 + r0 + 16 * i) * PA + C_RK + h * 256 + c0 * 8); }
#pragma unroll
        for (int i = 0; i < 8; ++i) { const int r = r0 + 16 * i; const float sc = exp2f(l2g * (float)(127 - r));
            *(u32x4*)(Vs + r * 272 + c0 * 8) = vv[i];
            u32x4 w; w.x = cvt_pk_bf16(bflo(kv[i].x) * sc, bfhi(kv[i].x) * sc); w.y = cvt_pk_bf16(bflo(kv[i].y) * sc, bfhi(kv[i].y) * sc);
            w.z = cvt_pk_bf16(bflo(kv[i].z) * sc, bfhi(kv[i].z) * sc); w.w = cvt_pk_bf16(bflo(kv[i].w) * sc, bfhi(kv[i].w) * sc);
            *(u32x4*)(Ks + r * 272 + c0 * 8) = w; }
    }
    __syncthreads();
    const int we = wave >> 2, wd = wave & 3;
    bf16_t* st = (bf16_t*)(p.ws + WS_STR) + (size_t)item * 65536;
    LAS unsigned char* l3 = (LAS unsigned char*)lds;
    bf16x8 bfr[4][4];
#pragma unroll
    for (int dt = 0; dt < 4; ++dt)
#pragma unroll
        for (int ks = 0; ks < 4; ++ks) bfr[dt][ks] = tr_frag_perm(l3 + 128 * 272 * 2, ks * 32, wd * 64 + dt * 16, 272, fr, fq);
    for (int et = 0; et < 8; ++et) {
        bf16x8 afr[4];
#pragma unroll
        for (int ks = 0; ks < 4; ++ks) afr[ks] = tr_frag_perm(l3, ks * 32, we * 128 + et * 16, 272, fr, fq);
        const int e = we * 128 + et * 16 + fr;
#pragma unroll
        for (int dt = 0; dt < 4; ++dt) {
            f32x4 acc = (f32x4){0.f, 0.f, 0.f, 0.f};
#pragma unroll
            for (int ks = 0; ks < 4; ++ks) acc = __builtin_amdgcn_mfma_f32_16x16x32_bf16(bfr[dt][ks], afr[ks], acc, 0, 0, 0);
            const int d = wd * 64 + dt * 16 + fq * 4;
            u32x2 w; w.x = cvt_pk_bf16(acc[0], acc[1]); w.y = cvt_pk_bf16(acc[2], acc[3]); *(u32x2*)(st + e * 256 + d) = w;
        }
    }
    __syncthreads();
}

__device__ __forceinline__ void hgrn_gates2(const Params& p, int layer, const bf16_t* projA, size_t t0, int h, int dp, int tg, float (&kk)[8][2], float (&bcl)[8][2]) {
    const float lb0 = hgrn_lower(p.lb, layer, h * 128 + 2 * dp), lb1 = hgrn_lower(p.lb, layer, h * 128 + 2 * dp + 1);
    const bf16_t* src = projA + (t0 + tg * 8) * PA + C_HF + h * 128 + 2 * dp;
    unsigned hw[8];
#pragma unroll
    for (int jj = 0; jj < 8; ++jj) hw[jj] = *(const unsigned*)(src + (size_t)jj * PA);
    float r0 = 0.f, r1 = 0.f;
#pragma unroll
    for (int jj = 0; jj < 8; ++jj) {
        const float s0 = frcp_(1.f + __expf(-bflo(hw[jj]))), s1 = frcp_(1.f + __expf(-bfhi(hw[jj])));
        const float k0 = (1.f - lb0) * (1.f - s0), k1 = (1.f - lb1) * (1.f - s1);
        kk[jj][0] = k0; kk[jj][1] = k1;
        r0 += __logf(fmaxf(1.f - k0, 1e-30f)); r1 += __logf(fmaxf(1.f - k1, 1e-30f));
        bcl[jj][0] = r0; bcl[jj][1] = r1;
    }
}

__device__ __forceinline__ void m1_hgrn(const Params& p, int layer, unsigned char* lds, int item) {
    const int tid = tid_fresh(), wave = tid >> 6, lane = tid & 63, fr = lane & 15, fq = lane >> 4;
    const int bh = item >> 6, n = item & 63, b = bh >> 3, h = bh & 7;
    const bf16_t* projA = (const bf16_t*)(p.ws + WS_PROJA);
    const size_t t0 = (size_t)b * SEQ + n * 64;
    float* TOT = (float*)lds;
    bf16_t* Vs = (bf16_t*)(lds + 4096);
    bf16_t* Kd = (bf16_t*)(lds + 4096 + 18432);
    const int dp = tid & 63, tg = tid >> 6;
    const int vr = tid >> 4, vc = tid & 15;
    const u32x4 v0 = *(const u32x4*)(projA + (t0 + vr) * PA + C_HI + h * 128 + vc * 8), v1 = *(const u32x4*)(projA + (t0 + vr + 32) * PA + C_HI + h * 128 + vc * 8);
    float kk[8][2], bcl[8][2];
    hgrn_gates2(p, layer, projA, t0, h, dp, tg, kk, bcl);
    TOT[tg * 128 + 2 * dp] = bcl[7][0]; TOT[tg * 128 + 2 * dp + 1] = bcl[7][1];
    *(u32x4*)(Vs + vr * 144 + vc * 8) = v0; *(u32x4*)(Vs + (vr + 32) * 144 + vc * 8) = v1;
    __syncthreads();
    {
        float t0s = 0.f, t1s = 0.f;
        for (int g = 7; g > tg; --g) { t0s += TOT[g * 128 + 2 * dp]; t1s += TOT[g * 128 + 2 * dp + 1]; }
        const float tot0 = bcl[7][0] + t0s, tot1 = bcl[7][1] + t1s;
#pragma unroll
        for (int jj = 0; jj < 8; ++jj)
            *(unsigned*)(Kd + (tg * 8 + jj) * 144 + 2 * dp) = cvt_pk_bf16(kk[jj][0] * __expf(tot0 - bcl[jj][0]), kk[jj][1] * __expf(tot1 - bcl[jj][1]));
        if (tg == 0) { float* hd = (float*)(p.ws + WS_HDEC) + (size_t)item * 128 + 2 * dp; hd[0] = __expf(tot0); hd[1] = __expf(tot1); }
    }
    __syncthreads();
    const int we = wave >> 2, wd = wave & 3;
    bf16_t* st = (bf16_t*)(p.ws + WS_STH) + (size_t)item * 16384;
    LAS unsigned char* l3 = (LAS unsigned char*)lds;
    bf16x8 bfr[2][2];
#pragma unroll
    for (int dt = 0; dt < 2; ++dt)
#pragma unroll
        for (int ks = 0; ks < 2; ++ks) bfr[dt][ks] = tr_frag_perm(l3 + 4096 + 18432, ks * 32, wd * 32 + dt * 16, 144, fr, fq);
#pragma unroll
    for (int et = 0; et < 4; ++et) {
        bf16x8 afr[2];
#pragma unroll
        for (int ks = 0; ks < 2; ++ks) afr[ks] = tr_frag_perm(l3 + 4096, ks * 32, we * 64 + et * 16, 144, fr, fq);
#pragma unroll
        for (int dt = 0; dt < 2; ++dt) {
            f32x4 acc = (f32x4){0.f, 0.f, 0.f, 0.f};
#pragma unroll
            for (int ks = 0; ks < 2; ++ks) acc = __builtin_amdgcn_mfma_f32_16x16x32_bf16(bfr[dt][ks], afr[ks], acc, 0, 0, 0);
            const int e = we * 64 + et * 16 + fr, dd = wd * 32 + dt * 16 + fq * 4;
            u32x2 w; w.x = cvt_pk_bf16(acc[0], acc[1]); w.y = cvt_pk_bf16(acc[2], acc[3]); *(u32x2*)(st + e * 128 + dd) = w;
        }
    }
    __syncthreads();
}

__device__ __forceinline__ void m1_kmean(const Params& p, unsigned char* lds, int item) {
    const int tid = tid_fresh();
    const int bh = item >> 4, blk = item & 15, b = bh >> 3, h = bh & 7;
    const bf16_t* projA = (const bf16_t*)(p.ws + WS_PROJA);
    const size_t t0 = (size_t)b * SEQ + blk * 256;
    const int c = tid & 15, rg = tid >> 4;
    u32x4 kv[8];
#pragma unroll
    for (int i = 0; i < 8; ++i) kv[i] = *(const u32x4*)(projA + (t0 + rg + 32 * i) * PA + C_MK + h * 128 + c * 8);
    float s[8] = {0.f, 0.f, 0.f, 0.f, 0.f, 0.f, 0.f, 0.f};
#pragma unroll
    for (int i = 0; i < 8; ++i) { s[0] += bflo(kv[i].x); s[1] += bfhi(kv[i].x); s[2] += bflo(kv[i].y); s[3] += bfhi(kv[i].y); s[4] += bflo(kv[i].z); s[5] += bfhi(kv[i].z); s[6] += bflo(kv[i].w); s[7] += bfhi(kv[i].w); }
    float* red = (float*)lds;
#pragma unroll
    for (int j = 0; j < 8; ++j) red[rg * 128 + c * 8 + j] = s[j];
    __syncthreads();
    if (tid < 128) { float t = 0.f;
#pragma unroll 8
        for (int r = 0; r < 32; ++r) t += red[r * 128 + tid];
        ((float*)(p.ws + WS_KMEAN))[(size_t)item * 128 + tid] = t * (1.f / 256.f); }
    __syncthreads();
}

__device__ __forceinline__ void m1_phase(const Params& p, int layer, unsigned char* lds) {
    for (int it = blockIdx.x; it < 512 + 2048 + 512; it += gridDim.x) {
        if (it < 512) m1_ret(p, lds, it);
        else if (it < 2560) m1_hgrn(p, layer, lds, it - 512);
        else m1_kmean(p, lds, it - 2560);
    }
}

__device__ __forceinline__ void m2_phase(const Params& p) {
    const int gt = blockIdx.x * 512 + tid_fresh(), ngt = gridDim.x * 512;
    for (int idx = gt; idx < 16 * 8192; idx += ngt) {
        const int bh = idx >> 13, off = (idx & 8191) * 8, h = bh & 3;
        const float cd = exp2f(ret_log2_gamma(h) * 128.f);
        bf16_t* base = (bf16_t*)(p.ws + WS_STR) + (size_t)bh * 32 * 65536 + off;
        float st[8];
#pragma unroll
        for (int i = 0; i < 8; ++i) st[i] = 0.f;
        for (int n0 = 0; n0 < 32; n0 += 8) {
            u32x4 kv[8];
#pragma unroll
            for (int j = 0; j < 8; ++j) kv[j] = *(const u32x4*)(base + (size_t)(n0 + j) * 65536);
#pragma unroll
            for (int j = 0; j < 8; ++j) {
                u32x4 o; o.x = cvt_pk_bf16(st[0], st[1]); o.y = cvt_pk_bf16(st[2], st[3]); o.z = cvt_pk_bf16(st[4], st[5]); o.w = cvt_pk_bf16(st[6], st[7]);
                *(u32x4*)(base + (size_t)(n0 + j) * 65536) = o;
                st[0] = cd * st[0] + bflo(kv[j].x); st[1] = cd * st[1] + bfhi(kv[j].x); st[2] = cd * st[2] + bflo(kv[j].y); st[3] = cd * st[3] + bfhi(kv[j].y);
                st[4] = cd * st[4] + bflo(kv[j].z); st[5] = cd * st[5] + bfhi(kv[j].z); st[6] = cd * st[6] + bflo(kv[j].w); st[7] = cd * st[7] + bfhi(kv[j].w);
            }
        }
    }
    for (int idx = gt; idx < 32 * 4096; idx += ngt) {
        const int bh = idx >> 12, off = (idx & 4095) * 4, d = off & 127;
        bf16_t* base = (bf16_t*)(p.ws + WS_STH) + (size_t)bh * 64 * 16384 + off;
        const float* dec = (const float*)(p.ws + WS_HDEC) + (size_t)bh * 64 * 128 + d;
        float st[4] = {0.f, 0.f, 0.f, 0.f};
        for (int n0 = 0; n0 < 64; n0 += 8) {
            u32x2 kv[8]; f32x4 dc[8];
#pragma unroll
            for (int j = 0; j < 8; ++j) { kv[j] = *(const u32x2*)(base + (size_t)(n0 + j) * 16384); dc[j] = *(const f32x4*)(dec + (n0 + j) * 128); }
#pragma unroll
            for (int j = 0; j < 8; ++j) {
                u32x2 o; o.x = cvt_pk_bf16(st[0], st[1]); o.y = cvt_pk_bf16(st[2], st[3]);
                *(u32x2*)(base + (size_t)(n0 + j) * 16384) = o;
                st[0] = dc[j].x * st[0] + bflo(kv[j].x); st[1] = dc[j].y * st[1] + bfhi(kv[j].x); st[2] = dc[j].z * st[2] + bflo(kv[j].y); st[3] = dc[j].w * st[3] + bfhi(kv[j].y);
            }
        }
    }
}

__device__ __forceinline__ void m3_ret(const Params& p, int layer, unsigned char* lds, int item) {
    const int tid = tid_fresh(), wave = tid >> 6, lane = tid & 63, fr = lane & 15, fq = lane >> 4;
    const int bh = item >> 5, n = item & 31, b = bh >> 2, h = bh & 3;
    const bf16_t* projA = (const bf16_t*)(p.ws + WS_PROJA);
    const size_t t0 = (size_t)b * SEQ + n * 128;
    bf16_t* R2 = (bf16_t*)lds;
    bf16_t* Ps = (bf16_t*)(lds + 69632);
    float* ST = (float*)(lds + 69632 + 34816);
    const float l2g = ret_log2_gamma(h);
    const int wi = wave >> 1, wc = wave & 1;
    const int cr = tid >> 5, cc = tid & 31;
    bf16x8 qf[2][8];
#pragma unroll
    for (int it = 0; it < 2; ++it)
#pragma unroll
        for (int ks = 0; ks < 8; ++ks) qf[it][ks] = *(const bf16x8*)(projA + (t0 + wi * 32 + it * 16 + fr) * PA + C_RQ + h * 256 + ks * 32 + fq * 8);
    u32x4 rr[8];
#pragma unroll
    for (int i = 0; i < 8; ++i) rr[i] = *(const u32x4*)(projA + (t0 + cr + 16 * i) * PA + C_RK + h * 256 + cc * 8);
#pragma unroll
    for (int i = 0; i < 8; ++i) *(u32x4*)(R2 + (cr + 16 * i) * 264 + cc * 8) = rr[i];
    const bf16_t* stg = (const bf16_t*)(p.ws + WS_STR) + (size_t)item * 65536;
#pragma unroll
    for (int i = 0; i < 8; ++i) rr[i] = *(const u32x4*)(stg + (size_t)(cr + 16 * i) * 256 + cc * 8);
    __syncthreads();
#pragma unroll
    for (int it = 0; it < 2; ++it)
#pragma unroll
        for (int jt = 0; jt < 4; ++jt) {
            const int jb = wc * 64 + jt * 16, ib = wi * 32 + it * 16;
            f32x4 a = (f32x4){0.f, 0.f, 0.f, 0.f};
            if (jb <= ib + 15) {
#pragma unroll
                for (int ks = 0; ks < 8; ++ks) { const bf16x8 kf = *(const bf16x8*)(R2 + (jb + fr) * 264 + ks * 32 + fq * 8);
                    a = __builtin_amdgcn_mfma_f32_16x16x32_bf16(kf, qf[it][ks], a, 0, 0, 0); }
            }
            const int i = ib + fr, j0 = jb + fq * 4;
            float pv[4];
#pragma unroll
            for (int jj = 0; jj < 4; ++jj) { const int rel = i - (j0 + jj); pv[jj] = rel >= 0 ? a[jj] * exp2f(l2g * (float)rel) : 0.f; }
            u32x2 w; w.x = cvt_pk_bf16(pv[0], pv[1]); w.y = cvt_pk_bf16(pv[2], pv[3]); *(u32x2*)(Ps + i * 136 + j0) = w;
        }
    __syncthreads();
    f32x4 acc[2][2][4];
#pragma unroll
    for (int a = 0; a < 2; ++a)
#pragma unroll
        for (int e = 0; e < 2; ++e)
#pragma unroll
            for (int t = 0; t < 4; ++t) acc[a][e][t] = (f32x4){0.f, 0.f, 0.f, 0.f};
#pragma unroll
    for (int eh = 0; eh < 2; ++eh) {
#pragma unroll
        for (int i = 0; i < 8; ++i) *(u32x4*)(R2 + (cr + 16 * i) * 264 + cc * 8) = rr[i];
        if (eh == 0) {
#pragma unroll
            for (int i = 0; i < 8; ++i) rr[i] = *(const u32x4*)(stg + (size_t)(128 + cr + 16 * i) * 256 + cc * 8);
        } else {
#pragma unroll
            for (int i = 0; i < 8; ++i) rr[i] = *(const u32x4*)(projA + (t0 + cr + 16 * i) * PA + C_RV + h * 256 + cc * 8);
        }
        __syncthreads();
#pragma unroll
        for (int e4 = 0; e4 < 4; ++e4)
#pragma unroll
            for (int ks = 0; ks < 8; ++ks) { const bf16x8 rf = *(const bf16x8*)(R2 + (wc * 64 + e4 * 16 + fr) * 264 + ks * 32 + fq * 8);
#pragma unroll
                for (int it = 0; it < 2; ++it) acc[it][eh][e4] = __builtin_amdgcn_mfma_f32_16x16x32_bf16(rf, qf[it][ks], acc[it][eh][e4], 0, 0, 0); }
        __syncthreads();
    }
#pragma unroll
    for (int it = 0; it < 2; ++it) { const float sc = exp2f(l2g * (float)(wi * 32 + it * 16 + fr + 1));
#pragma unroll
        for (int e = 0; e < 2; ++e)
#pragma unroll
            for (int t = 0; t < 4; ++t) acc[it][e][t] *= sc; }
#pragma unroll
    for (int i = 0; i < 8; ++i) *(u32x4*)(R2 + (cr + 16 * i) * 272 + cc * 8) = rr[i];
    __syncthreads();
    {
        LAS unsigned char* l3 = (LAS unsigned char*)lds;
#pragma unroll
        for (int ks = 0; ks < 4; ++ks) {
            bf16x8 pa[2];
#pragma unroll
            for (int it = 0; it < 2; ++it) pa[it] = row_frag_perm(Ps, 136, wi * 32 + it * 16, ks * 32, fr, fq);
#pragma unroll
            for (int eh = 0; eh < 2; ++eh)
#pragma unroll
                for (int e4 = 0; e4 < 4; ++e4) { const bf16x8 vb = tr_frag_perm(l3, ks * 32, eh * 128 + wc * 64 + e4 * 16, 272, fr, fq);
#pragma unroll
                    for (int it = 0; it < 2; ++it) acc[it][eh][e4] = __builtin_amdgcn_mfma_f32_16x16x32_bf16(vb, pa[it], acc[it][eh][e4], 0, 0, 0); }
        }
    }
#pragma unroll
    for (int it = 0; it < 2; ++it) {
        float s = 0.f, s2 = 0.f;
#pragma unroll
        for (int e = 0; e < 2; ++e)
#pragma unroll
            for (int t = 0; t < 4; ++t)
#pragma unroll
                for (int j = 0; j < 4; ++j) { const float v = acc[it][e][t][j]; s += v; s2 += v * v; }
        s += __shfl_xor(s, 16); s += __shfl_xor(s, 32); s2 += __shfl_xor(s2, 16); s2 += __shfl_xor(s2, 32);
        if (fq == 0) { ST[((wi * 32 + it * 16 + fr) * 2 + wc) * 2] = s; ST[((wi * 32 + it * 16 + fr) * 2 + wc) * 2 + 1] = s2; }
    }
    __syncthreads();
    bf16_t* ro = (bf16_t*)(p.ws + WS_BOUT);
    const float* rn = p.ret_norm + (size_t)layer * 1024 + h * 256;
#pragma unroll
    for (int it = 0; it < 2; ++it) {
        const int i = wi * 32 + it * 16 + fr;
        const float s = ST[i * 4] + ST[i * 4 + 2], s2 = ST[i * 4 + 1] + ST[i * 4 + 3];
        const float mu = s * (1.f / 256.f), var = fmaxf(s2 * (1.f / 256.f) - mu * mu, 0.f), rstd = __builtin_amdgcn_rsqf(var + EPS);
        const size_t tok = t0 + i;
#pragma unroll
        for (int eh = 0; eh < 2; ++eh)
#pragma unroll
            for (int e4 = 0; e4 < 4; ++e4) {
                const int e = eh * 128 + wc * 64 + e4 * 16 + fq * 4;
                const u32x2 g = *(const u32x2*)(projA + tok * PA + C_RG + h * 256 + e);
                const f32x4 nn = *(const f32x4*)(rn + e);
                const f32x4 v = acc[it][eh][e4];
                const float o0 = (v[0] - mu) * rstd * nn[0] * siluf_(bflo(g.x)), o1 = (v[1] - mu) * rstd * nn[1] * siluf_(bfhi(g.x));
                const float o2 = (v[2] - mu) * rstd * nn[2] * siluf_(bflo(g.y)), o3 = (v[3] - mu) * rstd * nn[3] * siluf_(bfhi(g.y));
                u32x2 w; w.x = cvt_pk_bf16(o0, o1); w.y = cvt_pk_bf16(o2, o3);
                *(u32x2*)(ro + tok * 1024 + h * 256 + e) = w;
            }
    }
    __syncthreads();
}

__device__ __forceinline__ void m3_hgrn(const Params& p, int layer, unsigned char* lds, int item) {
    const int tid = tid_fresh(), wave = tid >> 6, lane = tid & 63, fr = lane & 15, fq = lane >> 4;
    const int bh = item >> 6, n = item & 63, b = bh >> 3, h = bh & 7;
    const bf16_t* projA = (const bf16_t*)(p.ws + WS_PROJA);
    const size_t t0 = (size_t)b * SEQ + n * 64;
    float* TOT = (float*)lds;
    bf16_t* Qb = (bf16_t*)(lds + 4096);
    bf16_t* Qe = (bf16_t*)(lds + 21504);
    bf16_t* Ke = (bf16_t*)(lds + 38912);
    bf16_t* Ss = (bf16_t*)(lds + 82432);
    bf16_t* Vs = (bf16_t*)(lds + 117248);
    bf16_t* Ps = (bf16_t*)(lds + 135680);
    float* ST = (float*)(lds + 144896);
    const int dp = tid & 63, tg = tid >> 6;
    const int vr = tid >> 4, vc = tid & 15;
    const u32x4 v0 = *(const u32x4*)(projA + (t0 + vr) * PA + C_HI + h * 128 + vc * 8), v1 = *(const u32x4*)(projA + (t0 + vr + 32) * PA + C_HI + h * 128 + vc * 8);
    const bf16_t* sgl = (const bf16_t*)(p.ws + WS_STH) + (size_t)item * 16384;
    u32x4 sv[4];
#pragma unroll
    for (int i = 0; i < 4; ++i) sv[i] = *(const u32x4*)(sgl + (vr + 32 * i) * 128 + vc * 8);
    unsigned qw[8];
    { const bf16_t* src = projA + (t0 + tg * 8) * PA + C_HQ + h * 128 + 2 * dp;
#pragma unroll
      for (int jj = 0; jj < 8; ++jj) qw[jj] = *(const unsigned*)(src + (size_t)jj * PA); }
    float kk[8][2], bcl[8][2];
    hgrn_gates2(p, layer, projA, t0, h, dp, tg, kk, bcl);
    TOT[tg * 128 + 2 * dp] = bcl[7][0]; TOT[tg * 128 + 2 * dp + 1] = bcl[7][1];
    *(u32x4*)(Vs + vr * 144 + vc * 8) = v0; *(u32x4*)(Vs + (vr + 32) * 144 + vc * 8) = v1;
#pragma unroll
    for (int i = 0; i < 4; ++i) *(u32x4*)(Ss + (vr + 32 * i) * 136 + vc * 8) = sv[i];
    __syncthreads();
    {
        const int I = tg >> 1;
        const float* T0 = TOT + 2 * dp;
        float B0 = 0.f, B1 = 0.f;
        for (int g = 0; g < 2 * I; ++g) { B0 += T0[g * 128]; B1 += T0[g * 128 + 1]; }
        const float o0 = (tg & 1) ? T0[(2 * I) * 128] : 0.f, o1 = (tg & 1) ? T0[(2 * I) * 128 + 1] : 0.f;
        float ra0 = 0.f, ra1 = 0.f, rb0 = 0.f, rb1 = 0.f, rc0 = 0.f, rc1 = 0.f;
        if (I < 3) { ra0 = T0[(2 * I) * 128] + T0[(2 * I + 1) * 128]; ra1 = T0[(2 * I) * 128 + 1] + T0[(2 * I + 1) * 128 + 1]; }
        if (I < 2) { rb0 = ra0 + T0[(2 * I + 2) * 128] + T0[(2 * I + 3) * 128]; rb1 = ra1 + T0[(2 * I + 2) * 128 + 1] + T0[(2 * I + 3) * 128 + 1]; }
        if (I < 1) { rc0 = rb0 + T0[4 * 128] + T0[5 * 128]; rc1 = rb1 + T0[4 * 128 + 1] + T0[5 * 128 + 1]; }
#pragma unroll
        for (int jj = 0; jj < 8; ++jj) {
            const int i = tg * 8 + jj;
            const float bs0 = o0 + bcl[jj][0], bs1 = o1 + bcl[jj][1];
            const float qa = bflo(qw[jj]), qb2 = bfhi(qw[jj]);
            const float q0 = qa * frcp_(1.f + __expf(-qa)), q1 = qb2 * frcp_(1.f + __expf(-qb2));
            *(unsigned*)(Qb + i * 136 + 2 * dp) = cvt_pk_bf16(q0 * __expf(B0 + bs0), q1 * __expf(B1 + bs1));
            *(unsigned*)(Qe + i * 136 + 2 * dp) = cvt_pk_bf16(q0 * __expf(fmaxf(bs0, -80.f)), q1 * __expf(fmaxf(bs1, -80.f)));
            *(unsigned*)(Ke + (8 * I * (I + 1) + i) * 136 + 2 * dp) = cvt_pk_bf16(kk[jj][0] * __expf(fminf(-bs0, 80.f)), kk[jj][1] * __expf(fminf(-bs1, 80.f)));
            if (I < 3) *(unsigned*)(Ke + (8 * (I + 1) * (I + 2) + i) * 136 + 2 * dp) = cvt_pk_bf16(kk[jj][0] * __expf(ra0 - bs0), kk[jj][1] * __expf(ra1 - bs1));
            if (I < 2) *(unsigned*)(Ke + (8 * (I + 2) * (I + 3) + i) * 136 + 2 * dp) = cvt_pk_bf16(kk[jj][0] * __expf(rb0 - bs0), kk[jj][1] * __expf(rb1 - bs1));
            if (I < 1) *(unsigned*)(Ke + (96 + i) * 136 + 2 * dp) = cvt_pk_bf16(kk[jj][0] * __expf(rc0 - bs0), kk[jj][1] * __expf(rc1 - bs1));
        }
    }
    __syncthreads();
    const int wi = wave >> 2, wc = wave & 3;
    f32x4 acc[2][2];
#pragma unroll
    for (int it = 0; it < 2; ++it)
#pragma unroll
        for (int et = 0; et < 2; ++et) { acc[it][et] = (f32x4){0.f, 0.f, 0.f, 0.f};
            acc[it][et] = mma_tile<true>(Qb + (wi * 32 + it * 16) * 136, 136, Ss + (wc * 32 + et * 16) * 136, 136, 4, acc[it][et], lane); }
#pragma unroll
    for (int tt = 0; tt < 2; ++tt) {
        const int tix = wave * 2 + tt, I = tix >> 2, J = tix & 3;
        f32x4 a = (f32x4){0.f, 0.f, 0.f, 0.f};
        if (J <= I) a = mma_tile<true>(Qe + (I * 16) * 136, 136, Ke + (8 * I * (I + 1) + J * 16) * 136, 136, 4, a, lane);
        const int i = I * 16 + fr, j0 = J * 16 + fq * 4;
        float pv[4];
#pragma unroll
        for (int jj = 0; jj < 4; ++jj) pv[jj] = (J <= I && j0 + jj <= i) ? a[jj] : 0.f;
        u32x2 w; w.x = cvt_pk_bf16(pv[0], pv[1]); w.y = cvt_pk_bf16(pv[2], pv[3]); *(u32x2*)(Ps + i * 72 + j0) = w;
    }
    __syncthreads();
    {
        LAS unsigned char* l3 = (LAS unsigned char*)lds;
#pragma unroll
        for (int ks = 0; ks < 2; ++ks) {
            bf16x8 pa[2], vb[2];
#pragma unroll
            for (int it = 0; it < 2; ++it) pa[it] = row_frag_perm(Ps, 72, wi * 32 + it * 16, ks * 32, fr, fq);
#pragma unroll
            for (int et = 0; et < 2; ++et) vb[et] = tr_frag_perm(l3 + 117248, ks * 32, wc * 32 + et * 16, 144, fr, fq);
#pragma unroll
            for (int it = 0; it < 2; ++it)
#pragma unroll
                for (int et = 0; et < 2; ++et) acc[it][et] = __builtin_amdgcn_mfma_f32_16x16x32_bf16(vb[et], pa[it], acc[it][et], 0, 0, 0);
        }
    }
#pragma unroll
    for (int it = 0; it < 2; ++it) {
        float s2 = 0.f;
#pragma unroll
        for (int t = 0; t < 2; ++t)
#pragma unroll
            for (int j = 0; j < 4; ++j) { const float v = acc[it][t][j]; s2 += v * v; }
        s2 += __shfl_xor(s2, 16); s2 += __shfl_xor(s2, 32);
        if (fq == 0) ST[(wi * 32 + it * 16 + fr) * 4 + wc] = s2;
    }
    __syncthreads();
    bf16_t* ho = (bf16_t*)(p.ws + WS_BOUT) + (size_t)2 * NTOK * 1024;
    const float* hn = p.hgrn_norm + (size_t)layer * 1024 + h * 128;
#pragma unroll
    for (int it = 0; it < 2; ++it) {
        const int i = wi * 32 + it * 16 + fr;
        const float s2 = ST[i * 4] + ST[i * 4 + 1] + ST[i * 4 + 2] + ST[i * 4 + 3];
        const float rstd = __builtin_amdgcn_rsqf(s2 * (1.f / 128.f) + EPS);
        const size_t tok = t0 + i;
#pragma unroll
        for (int et = 0; et < 2; ++et) {
            const int e = wc * 32 + et * 16 + fq * 4;
            const u32x2 g = *(const u32x2*)(projA + tok * PA + C_HG + h * 128 + e);
            const f32x4 nn = *(const f32x4*)(hn + e);
            const f32x4 v = acc[it][et];
            u32x2 w; w.x = cvt_pk_bf16(v[0] * rstd * nn[0] * siluf_(bflo(g.x)), v[1] * rstd * nn[1] * siluf_(bfhi(g.x)));
            w.y = cvt_pk_bf16(v[2] * rstd * nn[2] * siluf_(bflo(g.y)), v[3] * rstd * nn[3] * siluf_(bfhi(g.y)));
            *(u32x2*)(ho + tok * 1024 + h * 128 + e) = w;
        }
    }
    __syncthreads();
}

__device__ __forceinline__ void m3_moba(const Params& p, unsigned char* lds, int item) {
    const int tid = tid_fresh(), wave = tid >> 6, lane = tid & 63, fr = lane & 15, fq = lane >> 4;
    const int bh = item & 31, qb = 15 - (item >> 5), b = bh >> 3, h = bh & 7;
    const bf16_t* projA = (const bf16_t*)(p.ws + WS_PROJA);
    const size_t tb = (size_t)b * SEQ;
    const int q0 = qb * 256;
    bf16_t* Qs = (bf16_t*)lds;
    float* KM = (float*)(lds + 69632);
    int* SEL = (int*)(lds + 77824);
    constexpr int KVB = 78912 + 1024, KVSZ = 17408 + 18432;
    stage_copy(projA + (tb + q0) * PA + C_MQ + h * 128, PA, 256, 128, Qs, 136, tid);
    { const float* km = (const float*)(p.ws + WS_KMEAN) + (size_t)bh * 2048; for (int i = tid; i < 2048; i += 512) KM[i] = km[i]; }
    if (tid == 0) SEL[256] = 0;
    __syncthreads();
    if (tid < 256) {
        float best0 = -INFINITY, best1 = -INFINITY, best2 = -INFINITY; int i0 = -1, i1 = -1, i2 = -1;
        for (int blk = 0; blk < qb; ++blk) {
            float sa = 0.f;
            for (int dd = 0; dd < 128; dd += 8) { const u32x4 qv = *(const u32x4*)(Qs + tid * 136 + dd); const float* kk = KM + blk * 128 + dd;
                sa += bflo(qv.x) * kk[0] + bfhi(qv.x) * kk[1] + bflo(qv.y) * kk[2] + bfhi(qv.y) * kk[3] + bflo(qv.z) * kk[4] + bfhi(qv.z) * kk[5] + bflo(qv.w) * kk[6] + bfhi(qv.w) * kk[7]; }
            if (sa > best0) { best2 = best1; i2 = i1; best1 = best0; i1 = i0; best0 = sa; i0 = blk; }
            else if (sa > best1) { best2 = best1; i2 = i1; best1 = sa; i1 = blk; }
            else if (sa > best2) { best2 = sa; i2 = blk; }
        }
        int mask = 0; if (i0 >= 0) mask |= 1 << i0; if (i1 >= 0) mask |= 1 << i1; if (i2 >= 0) mask |= 1 << i2;
        SEL[tid] = mask; atomicOr(&SEL[256], mask);
    }
    bf16x8 qf[2][4];
#pragma unroll
    for (int gi = 0; gi < 2; ++gi)
#pragma unroll
        for (int ks = 0; ks < 4; ++ks) qf[gi][ks] = *(const bf16x8*)(Qs + (wave * 32 + gi * 16 + fr) * 136 + ks * 32 + fq * 8);
    __syncthreads();
    if (tid == 0) {
        const int um = SEL[256]; int n = 0;
        for (int kt = 0; kt < 4; ++kt) SEL[264 + n++] = q0 + kt * 64;
        for (int kb = 0; kb < qb; ++kb) if ((um >> kb) & 1) for (int kt = 0; kt < 4; ++kt) SEL[264 + n++] = kb * 256 + kt * 64;
        SEL[257] = n;
    }
    __syncthreads();
    const int ntl = SEL[257];
    int mysel[2], qpos[2];
#pragma unroll
    for (int gi = 0; gi < 2; ++gi) { mysel[gi] = SEL[wave * 32 + gi * 16 + fr]; qpos[gi] = q0 + wave * 32 + gi * 16 + fr; }
    const float sl2 = 0.08838834764831845f * 1.4426950408889634f;
    float mneg[2] = {0.f, 0.f}, lrun[2] = {0.f, 0.f};
    f32x4 o[2][8];
#pragma unroll
    for (int gi = 0; gi < 2; ++gi)
#pragma unroll
        for (int et = 0; et < 8; ++et) o[gi][et] = (f32x4){0.f, 0.f, 0.f, 0.f};
    const int r0 = tid >> 4, c0 = tid & 15;
    const bf16_t* kg = projA + tb * PA + C_MK + h * 128 + c0 * 8;
    const bf16_t* vg = projA + tb * PA + C_MV + h * 128 + c0 * 8;
    u32x4 kr0, kr1, vr0, vr1;
    { const int key0 = SEL[264];
      kr0 = *(const u32x4*)(kg + (size_t)(key0 + r0) * PA); kr1 = *(const u32x4*)(kg + (size_t)(key0 + r0 + 32) * PA);
      vr0 = *(const u32x4*)(vg + (size_t)(key0 + r0) * PA); vr1 = *(const u32x4*)(vg + (size_t)(key0 + r0 + 32) * PA);
      bf16_t* Kb = (bf16_t*)(lds + KVB); bf16_t* Vb = (bf16_t*)(lds + KVB + 17408);
      *(u32x4*)(Kb + r0 * 136 + c0 * 8) = kr0; *(u32x4*)(Kb + (r0 + 32) * 136 + c0 * 8) = kr1;
      *(u32x4*)(Vb + r0 * 144 + c0 * 8) = vr0; *(u32x4*)(Vb + (r0 + 32) * 144 + c0 * 8) = vr1; }
    __syncthreads();
    for (int t = 0; t < ntl; ++t) {
        const int key0 = SEL[264 + t];
        const bool more = t + 1 < ntl;
        if (more) { const int kn = SEL[264 + t + 1];
            kr0 = *(const u32x4*)(kg + (size_t)(kn + r0) * PA); kr1 = *(const u32x4*)(kg + (size_t)(kn + r0 + 32) * PA);
            vr0 = *(const u32x4*)(vg + (size_t)(kn + r0) * PA); vr1 = *(const u32x4*)(vg + (size_t)(kn + r0 + 32) * PA); }
        const bf16_t* Kb = (const bf16_t*)(lds + KVB + (t & 1) * KVSZ); const bf16_t* Vb = Kb + 17408 / 2;
        const bool own = key0 >= q0; const int kb = key0 >> 8;
        if (!(own && key0 > q0 + wave * 32 + 31)) {
            f32x4 s[2][4];
            {
                bf16x8 kf[4][4];
#pragma unroll
                for (int nt = 0; nt < 4; ++nt)
#pragma unroll
                    for (int ks = 0; ks < 4; ++ks) kf[nt][ks] = *(const bf16x8*)(Kb + (nt * 16 + fr) * 136 + ks * 32 + fq * 8);
                __builtin_amdgcn_sched_barrier(0);
#pragma unroll
                for (int nt = 0; nt < 4; ++nt) { s[0][nt] = (f32x4){0.f, 0.f, 0.f, 0.f}; s[1][nt] = (f32x4){0.f, 0.f, 0.f, 0.f}; }
#pragma unroll
                for (int ks = 0; ks < 4; ++ks)
#pragma unroll
                    for (int nt = 0; nt < 4; ++nt) {
                        s[0][nt] = __builtin_amdgcn_mfma_f32_16x16x32_bf16(kf[nt][ks], qf[0][ks], s[0][nt], 0, 0, 0);
                        s[1][nt] = __builtin_amdgcn_mfma_f32_16x16x32_bf16(kf[nt][ks], qf[1][ks], s[1][nt], 0, 0, 0); }
            }
            bf16x8 pf[2][2];
#pragma unroll
            for (int gi = 0; gi < 2; ++gi) {
                if (t == 0) {
                    float mt = -INFINITY;
#pragma unroll
                    for (int nt = 0; nt < 4; ++nt)
#pragma unroll
                        for (int j = 0; j < 4; ++j) { const int key = key0 + nt * 16 + fq * 4 + j; mt = fmaxf(mt, key <= qpos[gi] ? s[gi][nt][j] * sl2 : -INFINITY); }
                    mt = fmaxf(mt, __shfl_xor(mt, 16)); mt = fmaxf(mt, __shfl_xor(mt, 32));
                    mneg[gi] = -mt;
                }
                float ls = 0.f;
                if (own) {
#pragma unroll
                    for (int nt = 0; nt < 4; ++nt)
#pragma unroll
                        for (int j = 0; j < 4; ++j) { const int key = key0 + nt * 16 + fq * 4 + j;
                            const float pv = __builtin_amdgcn_exp2f(key <= qpos[gi] ? __builtin_fmaf(s[gi][nt][j], sl2, mneg[gi]) : -INFINITY); s[gi][nt][j] = pv; ls += pv; }
                } else {
                    const float bias = ((mysel[gi] >> kb) & 1) ? mneg[gi] : -1e30f;
#pragma unroll
                    for (int nt = 0; nt < 4; ++nt)
#pragma unroll
                        for (int j = 0; j < 4; ++j) { const float pv = __builtin_amdgcn_exp2f(__builtin_fmaf(s[gi][nt][j], sl2, bias)); s[gi][nt][j] = pv; ls += pv; }
                }
                lrun[gi] += ls;
#pragma unroll
                for (int s2 = 0; s2 < 2; ++s2) { u32x4 pw; pw.x = cvt_pk_bf16(s[gi][2 * s2][0], s[gi][2 * s2][1]); pw.y = cvt_pk_bf16(s[gi][2 * s2][2], s[gi][2 * s2][3]);
                    pw.z = cvt_pk_bf16(s[gi][2 * s2 + 1][0], s[gi][2 * s2 + 1][1]); pw.w = cvt_pk_bf16(s[gi][2 * s2 + 1][2], s[gi][2 * s2 + 1][3]); pf[gi][s2] = __builtin_bit_cast(bf16x8, pw); }
            }
#pragma unroll
            for (int s2 = 0; s2 < 2; ++s2) {
                LAS unsigned char* vbase = (LAS unsigned char*)lds + KVB + (t & 1) * KVSZ + 17408;
                bf16x8 vf[8];
#pragma unroll
                for (int et = 0; et < 8; ++et) {
                    const int voff = ((s2 * 32 + fq * 4 + (fr >> 2)) * 144 + et * 16 + (fr & 3) * 4) * 2;
                    const s16x4 lo = __builtin_amdgcn_ds_read_tr16_b64_v4i16((LAS s16x4*)(vbase + voff));
                    const s16x4 hi = __builtin_amdgcn_ds_read_tr16_b64_v4i16((LAS s16x4*)(vbase + voff + 16 * 144 * 2));
                    vf[et] = __builtin_shufflevector(lo, hi, 0, 1, 2, 3, 4, 5, 6, 7);
                }
                __builtin_amdgcn_sched_barrier(0);
#pragma unroll
                for (int et = 0; et < 8; ++et) {
                    o[0][et] = __builtin_amdgcn_mfma_f32_16x16x32_bf16(vf[et], pf[0][s2], o[0][et], 0, 0, 0);
                    o[1][et] = __builtin_amdgcn_mfma_f32_16x16x32_bf16(vf[et], pf[1][s2], o[1][et], 0, 0, 0);
                }
            }
        }
        if (more) { bf16_t* Kn = (bf16_t*)(lds + KVB + ((t + 1) & 1) * KVSZ); bf16_t* Vn = Kn + 17408 / 2;
            *(u32x4*)(Kn + r0 * 136 + c0 * 8) = kr0; *(u32x4*)(Kn + (r0 + 32) * 136 + c0 * 8) = kr1;
            *(u32x4*)(Vn + r0 * 144 + c0 * 8) = vr0; *(u32x4*)(Vn + (r0 + 32) * 144 + c0 * 8) = vr1; }
        __syncthreads();
    }
    bf16_t* mo = (bf16_t*)(p.ws + WS_BOUT) + (size_t)NTOK * 1024;
#pragma unroll
    for (int gi = 0; gi < 2; ++gi) {
        float l = lrun[gi]; l += __shfl_xor(l, 16); l += __shfl_xor(l, 32);
        const float inv = 1.f / l;
        const size_t tok = tb + qpos[gi];
#pragma unroll
        for (int et = 0; et < 8; ++et) {
            u32x2 w; w.x = cvt_pk_bf16(o[gi][et][0] * inv, o[gi][et][1] * inv); w.y = cvt_pk_bf16(o[gi][et][2] * inv, o[gi][et][3] * inv);
            *(u32x2*)(mo + tok * 1024 + h * 128 + et * 16 + fq * 4) = w;
        }
    }
    __syncthreads();
}

__device__ __forceinline__ void m3_phase(const Params& p, int layer, unsigned char* lds, int rep = 0, int lo = 0, int hi = 3072) {
    unsigned* ctr = (unsigned*)(p.ws + WS_CTR) + layer * 16 + rep * 4;
    int* slot = (int*)(lds + LDS_ITEM_OFF);
    for (;;) {
        if (threadIdx.x == 0) *slot = (int)atomicAdd(ctr, 1u);
        __syncthreads();
        const int it = *slot + lo;
        __syncthreads();
        if (it >= hi) break;
        if (it < 512) m3_moba(p, lds, it);
        else if (it < 1024) m3_ret(p, layer, lds, it - 512);
        else m3_hgrn(p, layer, lds, it - 1024);
    }
}

__device__ __forceinline__ void final_norm_phase(const Params& p) {
    const int tid = tid_fresh(), wave = tid >> 6, lane = tid & 63;
    const int gw = blockIdx.x * 8 + wave, ngw = gridDim.x * 8;
    for (int r = gw; r < NTOK; r += ngw) {
        f32x4* xr = (f32x4*)(p.out + (size_t)r * DM) + lane;
        f32x4 v[8]; float s = 0.f;
#pragma unroll
        for (int j = 0; j < 8; ++j) { v[j] = xr[64 * j]; s += (v[j].x * v[j].x + v[j].y * v[j].y) + (v[j].z * v[j].z + v[j].w * v[j].w); }
        const float rstd = 1.f / sqrtf(wave_sum(s) * (1.f / DM) + EPS);
#pragma unroll
        for (int j = 0; j < 8; ++j) { const f32x4 gg = *((const f32x4*)p.final_norm + lane + 64 * j); f32x4 o = v[j] * rstd * gg;
            xr[64 * j] = o; }
    }
}


#define XB_TMO      128
#define XB_XCNT(j)  (256  + 64 * (j))
#define XB_XSUB(j)  (1280 + 64 * (j))
#define XB_XGEN(j)  (2304 + 64 * (j))
#define XB_TOP      3328
#define XB_TOPGEN   3392
#define XCD_BAR_WORDS 3456
#define XB_SPIN_CAP (1u << 18)
__device__ __forceinline__ unsigned xb_ld(unsigned* p)              { return __hip_atomic_load(p, __ATOMIC_RELAXED, __HIP_MEMORY_SCOPE_AGENT); }
__device__ __forceinline__ unsigned xb_add(unsigned* p, unsigned v) { return __hip_atomic_fetch_add(p, v, __ATOMIC_RELAXED, __HIP_MEMORY_SCOPE_AGENT); }
__device__ __forceinline__ unsigned xb_xcc_id() { return (unsigned)__builtin_amdgcn_s_getreg((3 << 11) | 20) & 0xFu; }
#define XB_SPIN(cond, bar) do { unsigned _sp = 0; while (cond) { __builtin_amdgcn_s_sleep(1); \
    if ((++_sp & 255u) == 0u) { if (xb_ld(&(bar)[XB_TMO])) break; if (_sp > XB_SPIN_CAP) { atomicAdd(&(bar)[XB_TMO], 1u); break; } } } } while (0)
struct XcdBarrier { unsigned* bar; unsigned x; volatile LAS unsigned* st; };
__device__ __forceinline__ XcdBarrier xcd_barrier_post(unsigned* bar, volatile LAS unsigned* st) {
    XcdBarrier b; b.bar = bar; b.x = xb_xcc_id(); b.st = st;
    if (threadIdx.x == 0) (void)xb_add(&bar[XB_XCNT(b.x)], 1u);
    return b;
}
__device__ __forceinline__ void xcd_barrier_complete(unsigned* bar, unsigned x, unsigned& nloc, unsigned& nx) {
    const unsigned G = gridDim.x * gridDim.y * gridDim.z;
    unsigned sum, cnt, mine, sp = 0u;
    for (;;) {
        sum = 0u; cnt = 0u; mine = 0u;
#pragma unroll
        for (unsigned j = 0; j < 16; ++j) { const unsigned c = xb_ld(&bar[XB_XCNT(j)]); sum += c; cnt += (c > 0u) ? 1u : 0u; mine = (j == x) ? c : mine; }
        if (sum == G) break;
        __builtin_amdgcn_s_sleep(1);
        if ((++sp & 255u) == 0u) { if (xb_ld(&bar[XB_TMO])) break; if (sp > XB_SPIN_CAP) { atomicAdd(&bar[XB_TMO], 1u); break; } }
    }
    nloc = mine > 0u ? mine : 1u; nx = cnt > 0u ? cnt : 1u;
}
__device__ __forceinline__ void xcd_barrier(const XcdBarrier& b) {
    asm volatile("s_waitcnt vmcnt(0)" ::: "memory");
    __syncthreads();
    if (threadIdx.x == 0) {
        unsigned* bar = b.bar;
        __builtin_amdgcn_s_waitcnt(0);
        unsigned nloc = b.st[0], nx = b.st[1];
        if (nloc == 0u) { xcd_barrier_complete(bar, b.x, nloc, nx); b.st[0] = nloc; b.st[1] = nx; }
        const unsigned old = xb_add(&bar[XB_XSUB(b.x)], 1u);
        const unsigned gen = old / nloc;
        if (old + 1u == (gen + 1u) * nloc) {
            __builtin_amdgcn_fence(__ATOMIC_RELEASE, "agent");
            asm volatile("s_waitcnt vmcnt(0)" ::: "memory");
            const unsigned og = xb_add(&bar[XB_TOP], 1u);
            const unsigned tg = og / nx;
            if (og + 1u == (tg + 1u) * nx) xb_add(&bar[XB_TOPGEN], 1u);
            else XB_SPIN(xb_ld(&bar[XB_TOPGEN]) == tg, bar);
            __builtin_amdgcn_fence(__ATOMIC_ACQUIRE, "agent");
            xb_add(&bar[XB_XGEN(b.x)], 1u);
            asm volatile("s_waitcnt vmcnt(0)" ::: "memory");
        } else {
            XB_SPIN(xb_ld(&bar[XB_XGEN(b.x)]) == gen, bar);
            __builtin_amdgcn_fence(__ATOMIC_ACQUIRE, "agent");
            asm volatile("s_waitcnt vmcnt(0)" ::: "memory");
        }
    }
    __syncthreads();
}

__global__ void __launch_bounds__(512, 2) fwd_megakernel(Params p) {
    extern __shared__ __attribute__((aligned(16))) unsigned char smem[];
    cg::grid_group grid = cg::this_grid();
    unsigned char* ws = p.ws;
    LAS unsigned char* lds3 = (LAS unsigned char*)smem;
    const int G = gridDim.x, c = blockIdx.x;
    prep_phase(p, 0, smem, p.x, p.norm_mix);
    { volatile LAS unsigned* stz = (volatile LAS unsigned*)(lds3 + LDS_BYTES - 32); if (threadIdx.x == 0) { stz[0] = 0u; stz[1] = 0u; } }
    grid.sync();
    const XcdBarrier xb = xcd_barrier_post((unsigned*)(ws + WS_XBAR), (volatile LAS unsigned*)(lds3 + LDS_BYTES - 32));
    for (int layer = 0; layer < DEPTH; ++layer) {
        const float* xin = layer == 0 ? p.x : p.out;
        {
            pg8::Sched S; S.init(NTOK, INC, DM, G, c, 1); S.A0 = (const bf16_t*)(ws + WS_HB); S.B0 = (const bf16_t*)(ws + WS_WIN); S.zsA = 0; S.zsB = 0;
            EpiIn E; E.projA = (bf16_t*)(ws + WS_PROJA); E.gates = (bf16_t*)(ws + WS_GATES); E.ropeR = (const float*)(ws + WS_ROPER); E.ropeM = (const float*)(ws + WS_ROPEM);
            pg8::gemm_phase(lds3, S, E);
        }
        xcd_barrier(xb);
        m1_phase(p, layer, smem);
        xcd_barrier(xb);
        m2_phase(p);
        xcd_barrier(xb);
        m3_phase(p, layer, smem);
        xcd_barrier(xb);
        {
            pg8::Sched S; S.init(NTOK, DM, 1024, G, c, 3);
            S.A0 = (const bf16_t*)(ws + WS_BOUT); S.zsA = (size_t)NTOK * 1024; S.B0 = (const bf16_t*)(ws + WS_WBR); S.zsB = E_WBR;
            EpiBr E; E.gates = (const bf16_t*)(ws + WS_GATES); E.mixb = (bf16_t*)(ws + WS_MIXB);
            pg8::gemm_phase(lds3, S, E);
        }
        xcd_barrier(xb);
        {
            pg8::Sched S; S.init(NTOK, DM, DM, G, c, 1); S.A0 = (const bf16_t*)(ws + WS_MIXB); S.B0 = (const bf16_t*)(ws + WS_WOUT); S.zsA = 0; S.zsB = 0;
            EpiRes E; E.xin = xin; E.xout = p.out;
            pg8::gemm_phase(lds3, S, E);
        }
        xcd_barrier(xb);
        {
            const int tq = tid_fresh(); const int wave = tq >> 6, lane = tq & 63;
            rmsnorm_rows_bf16(p.out, p.norm_ffn + (size_t)layer * DM, (bf16_t*)(ws + WS_HB), c * 8 + wave, G * 8, lane);
        }
        xcd_barrier(xb);
        {
            pg8::Sched S; S.init(NTOK, 2 * FH, DM, G, c, 1); S.A0 = (const bf16_t*)(ws + WS_HB); S.B0 = (const bf16_t*)(ws + WS_WGU); S.zsA = 0; S.zsB = 0;
            EpiGU E; E.ffh = (bf16_t*)(ws + WS_FFH);
            pg8::gemm_phase(lds3, S, E);
        }
        xcd_barrier(xb);
        {
            pg8::Sched S; S.init(NTOK, DM, FH, G, c, 1); S.A0 = (const bf16_t*)(ws + WS_FFH); S.B0 = (const bf16_t*)(ws + WS_WDN); S.zsA = 0; S.zsB = 0;
            EpiRes E; E.xin = p.out; E.xout = p.out;
            pg8::gemm_phase(lds3, S, E);
        }
        xcd_barrier(xb);
        if (layer + 1 < DEPTH) { prep_phase(p, layer + 1, smem, p.out, p.norm_mix + (size_t)(layer + 1) * DM); xcd_barrier(xb);
        }
    }
    final_norm_phase(p);
}

extern "C" void kernel_launch(void* const* d_in, const int* in_sizes, int n_in, void* d_out, int out_size, void* d_ws, size_t ws_size, hipStream_t stream) {
    static int grid_blocks = 0;
    if (grid_blocks == 0) {
        if (n_in != 15 || out_size != NTOK * DM || ws_size < WS_END) { fprintf(stderr, "kernel_launch: unexpected shapes (n_in %d out %d ws %zu need %zu)\n", n_in, out_size, ws_size, (size_t)WS_END); grid_blocks = -1; return; }
        int dev = 0, cus = 0, per_cu = 0;
        hipGetDevice(&dev);
        hipDeviceGetAttribute(&cus, hipDeviceAttributeMultiprocessorCount, dev);
        if (hipFuncSetAttribute((const void*)fwd_megakernel, hipFuncAttributeMaxDynamicSharedMemorySize, LDS_BYTES) != hipSuccess) { fprintf(stderr, "kernel_launch: hipFuncSetAttribute failed\n"); }
        if (hipOccupancyMaxActiveBlocksPerMultiprocessor(&per_cu, (const void*)fwd_megakernel, 512, LDS_BYTES) != hipSuccess || per_cu < 1) { fprintf(stderr, "kernel_launch: occupancy query gave %d\n", per_cu); per_cu = 1; }
        (void)hipGetLastError();
        grid_blocks = cus;
        if (grid_blocks > 256) grid_blocks = 256;
    }
    if (grid_blocks < 0) return;
    Params p{};
    p.x = (const float*)d_in[0]; p.lb = (const float*)d_in[1]; p.norm_mix = (const float*)d_in[2]; p.w_in = (const float*)d_in[3]; p.ret_norm = (const float*)d_in[4]; p.hgrn_norm = (const float*)d_in[5];
    p.w_br[0] = (const float*)d_in[6]; p.w_br[1] = (const float*)d_in[7]; p.w_br[2] = (const float*)d_in[8]; p.w_out = (const float*)d_in[9]; p.norm_ffn = (const float*)d_in[10];
    p.w_gate = (const float*)d_in[11]; p.w_up = (const float*)d_in[12]; p.w_down = (const float*)d_in[13]; p.final_norm = (const float*)d_in[14];
    p.out = (float*)d_out; p.ws = (unsigned char*)d_ws;
    void* args[] = {&p};
    hipError_t e = hipLaunchCooperativeKernel((const void*)fwd_megakernel, dim3(grid_blocks), dim3(512), args, LDS_BYTES, stream);
    if (e != hipSuccess) fprintf(stderr, "cooperative launch failed: %s (grid %d)\n", hipGetErrorString(e), grid_blocks);
}
```

```cpp
#include <hip/hip_runtime.h>
#include <hip/hip_cooperative_groups.h>
#include <cstdio>
namespace cg = cooperative_groups;

#define LAS __attribute__((address_space(3)))
typedef unsigned short bf16_t;
typedef short bf16x8 __attribute__((ext_vector_type(8)));
typedef short bf16x4 __attribute__((ext_vector_type(4)));
typedef float f32x4 __attribute__((ext_vector_type(4)));
typedef unsigned u32x4 __attribute__((ext_vector_type(4)));
typedef unsigned u32x2 __attribute__((ext_vector_type(2)));

constexpr int DM = 2048, SEQ = 4096, NTOK = 16384, DEPTH = 2;
constexpr int INC = 17408, PA = 11264, GC = 6144, FH = 5632;
constexpr int C_RQ = 0, C_RK = 1024, C_RV = 2048, C_RG = 3072, C_MQ = 4096, C_MK = 5120, C_MV = 6144, C_HQ = 7168, C_HF = 8192, C_HI = 9216, C_HG = 10240;
constexpr float EPS = 1e-6f;

constexpr size_t E_WIN = (size_t)DM * INC, E_WBR = (size_t)1024 * DM, E_WOUT = (size_t)DM * DM, E_WGU = (size_t)2 * DM * FH, E_WDN = (size_t)FH * DM;
constexpr size_t WS_WIN = 0;
constexpr size_t WS_WBR = WS_WIN + E_WIN * 2;
constexpr size_t WS_WOUT = WS_WBR + 3 * E_WBR * 2;
constexpr size_t WS_WGU = WS_WOUT + E_WOUT * 2;
constexpr size_t WS_WDN = WS_WGU + E_WGU * 2;
constexpr size_t WS_HB = WS_WDN + E_WDN * 2;
constexpr size_t WS_PROJA = WS_HB + (size_t)NTOK * DM * 2;
constexpr size_t WS_MIXB = WS_PROJA;
constexpr size_t WS_MIX32 = WS_PROJA + (size_t)NTOK * DM * 2;
constexpr size_t WS_FFH = WS_MIX32;
constexpr size_t WS_GATES = WS_PROJA + (size_t)NTOK * PA * 2;
constexpr size_t WS_BOUT = WS_GATES + (size_t)NTOK * GC * 2;
constexpr size_t WS_STR = WS_BOUT + (size_t)3 * NTOK * 1024 * 2;
constexpr size_t WS_STH = WS_STR + (size_t)512 * 65536 * 2;
constexpr size_t WS_HDEC = WS_STH + (size_t)2048 * 16384 * 2;
constexpr size_t WS_KMEAN = WS_HDEC + (size_t)2048 * 128 * 4;
constexpr size_t WS_ROPER = WS_KMEAN + (size_t)512 * 128 * 4;
constexpr size_t WS_ROPEM = WS_ROPER + (size_t)2 * 4096 * 128 * 4;
constexpr size_t WS_CTR = WS_ROPEM + (size_t)2 * 4096 * 16 * 4;
constexpr size_t WS_XBAR = WS_CTR + 256;
constexpr size_t WS_END = WS_XBAR + 3456 * 4;

constexpr int LDS_BYTES = 160 * 1024;
constexpr int LDS_ITEM_OFF = LDS_BYTES - 16;

struct Params {
    const float* x; const float* lb; const float* norm_mix; const float* w_in; const float* ret_norm; const float* hgrn_norm;
    const float* w_br[3]; const float* w_out; const float* norm_ffn; const float* w_gate; const float* w_up; const float* w_down; const float* final_norm;
    float* out; unsigned char* ws;
};

typedef __bf16 bf16v2_t __attribute__((ext_vector_type(2)));
typedef float f32x2_t __attribute__((ext_vector_type(2)));
__device__ __forceinline__ unsigned cvt_pk_bf16(float lo, float hi) { const f32x2_t v = {lo, hi}; const bf16v2_t b = __builtin_convertvector(v, bf16v2_t); return __builtin_bit_cast(unsigned, b); }
__device__ __forceinline__ float bf2f(unsigned short b) { return __uint_as_float(((unsigned)b) << 16); }
__device__ __forceinline__ float bflo(unsigned w) { return __uint_as_float(w << 16); }
__device__ __forceinline__ float bfhi(unsigned w) { return __uint_as_float(w & 0xffff0000u); }
__device__ __forceinline__ float frcp_(float x) { return __builtin_amdgcn_rcpf(x); }
__device__ __forceinline__ float sigmoidf_(float v) { return frcp_(1.f + __expf(-v)); }
__device__ __forceinline__ float siluf_(float v) { return v * frcp_(1.f + __expf(-v)); }
__device__ __forceinline__ int tid_fresh() { int t = threadIdx.x; asm volatile("" : "+v"(t)); return t; }
__device__ __forceinline__ float wave_sum(float v) {
#pragma unroll
    for (int o = 1; o < 64; o <<= 1) v += __shfl_xor(v, o);
    return v;
}

namespace pg8 {
constexpr int BM = 256, BK = 64, HALF = 128, HTB = HALF * BK * 2, STAGE_BYTES = 8 * HTB, NXCD = 8, WGM = 8;
__host__ __device__ __forceinline__ int lds_byte(int r, int c) { const int st = (r >> 4) * 2 + (c >> 5), rr = r & 15, cc = c & 31, ob = rr * 64 + cc * 2; return st * 1024 + (ob ^ (((ob >> 9) & 1) << 5)); }
__host__ __device__ __forceinline__ void stage_rc(int b, int& R, int& C) { const int st = b / 1024, sb = b % 1024, swz = sb ^ (((sb >> 9) & 1) << 5); R = (st >> 1) * 16 + swz / 64; C = (st & 1) * 32 + (swz % 64) / 2; }
__host__ __device__ __forceinline__ int perm32(int rho) { const int n = rho >> 4, i = rho & 15; return 8 * (i >> 2) + 4 * n + (i & 3); }

struct Unit { int pm, pn, z; };
struct Sched {
    int nM, nN, nwg, G, c, nz, K;
    const bf16_t* A0; const bf16_t* B0; size_t zsA, zsB;
    __device__ void init(int M, int N, int K_, int G_, int c_, int nz_) { nM = M / BM; nN = N / BM; nwg = nM * nN; G = G_; c = c_; nz = nz_; K = K_; }
    __device__ bool next(int i, Unit& u) const {
        const int r = i / nz; u.z = i - r * nz;
        const long L = (long)r * G + c; if (L >= nwg) return false;
        int wgid = (int)L; { const int q = nwg / NXCD, rr = nwg % NXCD, xcd = wgid % NXCD, off = wgid / NXCD; wgid = (xcd < rr ? xcd * (q + 1) : rr * (q + 1) + (xcd - rr) * q) + off; }
        const int nig = WGM * nN, gid = wgid / nig, fm = gid * WGM, gsz = (nM - fm) < WGM ? (nM - fm) : WGM;
        u.pm = fm + ((wgid % nig) % gsz); u.pn = (wgid % nig) / gsz; return true;
    }
    __device__ __forceinline__ const char* baseA(const Unit& u) const { return (const char*)(A0 + (size_t)u.z * zsA) + (size_t)u.pm * (size_t)BM * K * 2; }
    __device__ __forceinline__ const char* baseB(const Unit& u) const { return (const char*)(B0 + (size_t)u.z * zsB) + (size_t)u.pn * (size_t)BM * K * 2; }
};

template <class Epi>
__device__ __forceinline__ void gemm_phase(LAS unsigned char* lds, const Sched& S, const Epi& E) {
    const int tid = tid_fresh(), wid = __builtin_amdgcn_readfirstlane(tid >> 6), lane = tid & 63, wr = wid >> 2, wc = wid & 3, fr = lane & 15, fq = lane >> 4;
    const int K = S.K, nt = K / BK;
    unsigned voffA[2], voffB[2];
#pragma unroll
    for (int i = 0; i < 2; ++i) { int R, C; stage_rc(tid * 16 + i * 8192, R, C); const int Rb = Epi::PERM ? ((R & ~31) + perm32(R & 31)) : R;
        voffA[i] = (unsigned)(R * K + C) * 2u; voffB[i] = (unsigned)(Rb * K + C) * 2u; }
    const size_t kstep = (size_t)(BK * 2);
    const size_t hstep = (size_t)HALF * K * 2;
    const unsigned ldsw = (unsigned)wid * 1024u;
    const int aoff = lds_byte(wr * 64 + fr, fq * 8), boff = lds_byte(wc * 32 + fr, fq * 8);
#define PG8_SA(b, h) (((b) * 2 + (h)) * HTB)
#define PG8_SB(b, h) ((4 + (b) * 2 + (h)) * HTB)
#define PG8_STAGE(bufoff, gbase, voff) do { _Pragma("unroll") for (int _i = 0; _i < 2; ++_i) \
        __builtin_amdgcn_global_load_lds((const unsigned*)((const char*)(gbase) + (voff)[_i]), (LAS unsigned*)(lds + (bufoff) + ldsw + _i * 8192), 16, 0, 0); } while (0)
#define PG8_LDA(dst, b, h) do { _Pragma("unroll") for (int m = 0; m < 4; ++m) _Pragma("unroll") for (int k = 0; k < 2; ++k) dst[m][k] = *(const LAS bf16x8*)(lds + PG8_SA(b, h) + aoff + m * 2048 + k * 1024); } while (0)
#define PG8_LDB(dst, b, h) do { _Pragma("unroll") for (int n = 0; n < 2; ++n) _Pragma("unroll") for (int k = 0; k < 2; ++k) dst[n][k] = *(const LAS bf16x8*)(lds + PG8_SB(b, h) + boff + n * 2048 + k * 1024); } while (0)
#define PG8_MMA(ai, bj, At, Bt) do { __builtin_amdgcn_s_setprio(1); _Pragma("unroll") for (int m = 0; m < 4; ++m) _Pragma("unroll") for (int n = 0; n < 2; ++n) _Pragma("unroll") for (int k = 0; k < 2; ++k) \
        acc[ai][bj][m][n] = __builtin_amdgcn_mfma_f32_16x16x32_bf16(Bt[n][k], At[m][k], acc[ai][bj][m][n], 0, 0, 0); __builtin_amdgcn_s_setprio(0); } while (0)
#define PG8_WAIT_V(n) asm volatile("s_waitcnt vmcnt(" #n ")" ::: "memory")
#define PG8_WAIT_L(n) asm volatile("s_waitcnt lgkmcnt(" #n ")" ::: "memory")
#define PG8_BAR __builtin_amdgcn_s_barrier()
#define PG8_SCHED __builtin_amdgcn_sched_barrier(0)
    Unit cur, nxt; int ui = 0;
    if (!S.next(0, cur)) return;
    f32x4 acc[2][2][4][2];
#pragma unroll
    for (int a = 0; a < 2; ++a)
#pragma unroll
        for (int b = 0; b < 2; ++b)
#pragma unroll
            for (int m = 0; m < 4; ++m)
#pragma unroll
                for (int n = 0; n < 2; ++n) acc[a][b][m][n] = (f32x4){0.f, 0.f, 0.f, 0.f};
    bf16x8 At[4][2], B0[2][2], B1[2][2];
    const char* cA = S.baseA(cur); const char* cB = S.baseB(cur);
    PG8_STAGE(PG8_SB(0, 0), cB, voffB); PG8_STAGE(PG8_SB(0, 1), cB + hstep, voffB); PG8_STAGE(PG8_SA(0, 0), cA, voffA); PG8_STAGE(PG8_SA(0, 1), cA + hstep, voffA);
    if (wr == 1) PG8_BAR;
    PG8_WAIT_V(2); PG8_BAR;
    PG8_STAGE(PG8_SB(1, 0), cB + kstep, voffB); PG8_STAGE(PG8_SA(1, 0), cA + kstep, voffA); PG8_STAGE(PG8_SB(1, 1), cB + hstep + kstep, voffB);
    PG8_WAIT_V(6); PG8_BAR;
    for (;;) {
        const bool has_next = S.next(ui + 1, nxt);
        const char* nA = has_next ? S.baseA(nxt) : cA; const char* nB = has_next ? S.baseB(nxt) : cB;
        for (int t = 0; t < nt; t += 2) {
            const bool last = (t == nt - 2);
            const char* a1 = cA + (size_t)(t + 1) * kstep;
            const char* a2 = last ? nA : cA + (size_t)(t + 2) * kstep; const char* b2 = last ? nB : cB + (size_t)(t + 2) * kstep;
            const char* a3 = a2 + kstep; const char* b3 = b2 + kstep;
            PG8_LDB(B0, 0, 0); PG8_LDB(B1, 0, 1); PG8_SCHED; PG8_LDA(At, 0, 0); PG8_STAGE(PG8_SA(1, 1), a1 + hstep, voffA);
            PG8_WAIT_V(8); PG8_WAIT_L(0); PG8_BAR; PG8_MMA(0, 0, At, B0); PG8_MMA(0, 1, At, B1); PG8_BAR; PG8_SCHED;
            PG8_LDA(At, 0, 1); PG8_STAGE(PG8_SB(0, 0), b2, voffB); PG8_STAGE(PG8_SB(0, 1), b2 + hstep, voffB); PG8_STAGE(PG8_SA(0, 0), a2, voffA);
            PG8_WAIT_V(8); PG8_WAIT_L(0); PG8_BAR; PG8_MMA(1, 0, At, B0); PG8_MMA(1, 1, At, B1); PG8_BAR; PG8_SCHED;
            PG8_LDB(B0, 1, 0); PG8_LDB(B1, 1, 1); PG8_SCHED; PG8_LDA(At, 1, 0); PG8_STAGE(PG8_SA(0, 1), a2 + hstep, voffA);
            PG8_WAIT_V(8); PG8_WAIT_L(0); PG8_BAR; PG8_MMA(0, 0, At, B0); PG8_MMA(0, 1, At, B1); PG8_BAR; PG8_SCHED;
            PG8_LDA(At, 1, 1); PG8_STAGE(PG8_SB(1, 0), b3, voffB); PG8_STAGE(PG8_SB(1, 1), b3 + hstep, voffB); PG8_STAGE(PG8_SA(1, 0), a3, voffA);
            PG8_WAIT_V(8); PG8_WAIT_L(0); PG8_BAR; PG8_MMA(1, 0, At, B0); PG8_MMA(1, 1, At, B1); PG8_BAR; PG8_SCHED;
        }
        bool keep = false;
        if constexpr (Epi::ZACC) { if (cur.z + 1 < S.nz) { E.mid(acc, cur, wr, wc, fr, fq); keep = true; } }
        if (!keep) E(acc, cur, wr, wc, fr, fq);
        if (!has_next) break;
        if (!keep)
        {
#pragma unroll
        for (int a = 0; a < 2; ++a)
#pragma unroll
            for (int b = 0; b < 2; ++b)
#pragma unroll
                for (int m = 0; m < 4; ++m)
#pragma unroll
                    for (int n = 0; n < 2; ++n) acc[a][b][m][n] = (f32x4){0.f, 0.f, 0.f, 0.f};
        }
        cur = nxt; cA = nA; cB = nB; ++ui;
    }
    PG8_WAIT_V(0);
    if (wr == 0) PG8_BAR;
    PG8_BAR;
#undef PG8_SA
#undef PG8_SB
#undef PG8_STAGE
#undef PG8_LDA
#undef PG8_LDB
#undef PG8_MMA
#undef PG8_WAIT_V
#undef PG8_WAIT_L
#undef PG8_BAR
#undef PG8_SCHED
}
}
using pg8::Unit;
typedef f32x4 AccT[2][2][4][2];

struct EpiIn {
    static constexpr bool PERM = true; static constexpr bool ZACC = false;
    bf16_t* projA; bf16_t* gates; const float* ropeR; const float* ropeM;
    __device__ __forceinline__ void operator()(AccT& acc, const Unit& u, int wr, int wc, int fr, int fq) const {
        const int pn = u.pn;
        const int row0 = u.pm * 256 + wr * 64 + fr;
        bf16_t* base; int ld, colt;
        if (pn < 44) { base = projA; ld = PA; colt = pn * 256; } else { base = gates; ld = GC; colt = (pn - 44) * 256; }
        const int col0 = colt + wc * 32 + 8 * fq;
        const int kind = pn < 8 ? 1 : ((pn >= 16 && pn < 24 && wc == 0) ? 2 : 0);
        const float* rt = kind == 1 ? ropeR : ropeM; const int rld = kind == 1 ? 128 : 16;
        const int i0 = kind == 1 ? wc * 32 + 8 * fq : 8 * (fq & 1);
        const float sc = (kind == 1 && pn >= 4) ? 0.0625f : 1.f;
        f32x4 cc[2], ss[2], cn[2], sn[2];
#pragma unroll
        for (int n = 0; n < 2; ++n) { cc[n] = ss[n] = cn[n] = sn[n] = (f32x4){0.f, 0.f, 0.f, 0.f}; }
        if (kind) { const int pos = row0 & (SEQ - 1);
#pragma unroll
            for (int n = 0; n < 2; ++n) { cc[n] = *(const f32x4*)(rt + (size_t)pos * rld + i0 + 4 * n); ss[n] = *(const f32x4*)(rt + (size_t)(SEQ + pos) * rld + i0 + 4 * n); } }
#pragma unroll
        for (int g = 0; g < 8; ++g) {
            const int ai = g >> 2, m = g & 3, row = row0 + ai * 128 + m * 16;
            if (kind && g < 7) { const int pos2 = (row0 + ((g + 1) >> 2) * 128 + ((g + 1) & 3) * 16) & (SEQ - 1);
#pragma unroll
                for (int n = 0; n < 2; ++n) { cn[n] = *(const f32x4*)(rt + (size_t)pos2 * rld + i0 + 4 * n); sn[n] = *(const f32x4*)(rt + (size_t)(SEQ + pos2) * rld + i0 + 4 * n); } }
            f32x4 v[2][2];
#pragma unroll
            for (int bj = 0; bj < 2; ++bj)
#pragma unroll
                for (int n = 0; n < 2; ++n) v[bj][n] = acc[ai][bj][m][n];
            if (kind == 1) {
#pragma unroll
                for (int n = 0; n < 2; ++n) { const f32x4 x1 = v[0][n], x2 = v[1][n];
                    v[0][n] = (x1 * cc[n] - x2 * ss[n]) * sc; v[1][n] = (x2 * cc[n] + x1 * ss[n]) * sc; }
            } else if (kind == 2) {
#pragma unroll
                for (int n = 0; n < 2; ++n) { const f32x4 sg = fq < 2 ? -ss[n] : ss[n];
#pragma unroll
                    for (int bj = 0; bj < 2; ++bj) { f32x4 p;
#pragma unroll
                        for (int j = 0; j < 4; ++j) p[j] = __shfl_xor(v[bj][n][j], 32);
                        v[bj][n] = v[bj][n] * cc[n] + p * sg; } }
            }
            bf16_t* rowp = base + (size_t)row * ld + col0;
#pragma unroll
            for (int bj = 0; bj < 2; ++bj) {
                u32x4 w; w.x = cvt_pk_bf16(v[bj][0][0], v[bj][0][1]); w.y = cvt_pk_bf16(v[bj][0][2], v[bj][0][3]); w.z = cvt_pk_bf16(v[bj][1][0], v[bj][1][1]); w.w = cvt_pk_bf16(v[bj][1][2], v[bj][1][3]);
                *(u32x4*)(rowp + bj * 128) = w;
            }
#pragma unroll
            for (int n = 0; n < 2; ++n) { cc[n] = cn[n]; ss[n] = sn[n]; }
        }
    }
};
struct EpiBr {
    static constexpr bool PERM = false; static constexpr bool ZACC = true;
    const bf16_t* gates; bf16_t* mixb;
    __device__ __forceinline__ void mid(AccT& acc, const Unit& u, int wr, int wc, int fr, int fq) const {
        const int row0 = u.pm * 256 + wr * 64 + fr, col0 = u.pn * 256 + wc * 32 + 4 * fq, z = u.z;
        u32x2 ac[2][2], bc[2][2], an[2][2], bn[2][2];
#pragma unroll
        for (int bj = 0; bj < 2; ++bj)
#pragma unroll
            for (int n = 0; n < 2; ++n) { const bf16_t* gp = gates + (size_t)row0 * GC + z * DM + col0 + bj * 128 + n * 16; ac[bj][n] = *(const u32x2*)gp; bc[bj][n] = *(const u32x2*)(gp + DM); }
#pragma unroll
        for (int g = 0; g < 8; ++g) {
            const int ai = g >> 2, m = g & 3;
            if (g < 7) { const int row2 = row0 + ((g + 1) >> 2) * 128 + ((g + 1) & 3) * 16;
#pragma unroll
                for (int bj = 0; bj < 2; ++bj)
#pragma unroll
                    for (int n = 0; n < 2; ++n) { const bf16_t* gp = gates + (size_t)row2 * GC + z * DM + col0 + bj * 128 + n * 16; an[bj][n] = *(const u32x2*)gp; bn[bj][n] = *(const u32x2*)(gp + DM); } }
#pragma unroll
            for (int bj = 0; bj < 2; ++bj)
#pragma unroll
                for (int n = 0; n < 2; ++n) {
                    const u32x2 ga = ac[bj][n], gb = bc[bj][n];
                    f32x4 v = acc[ai][bj][m][n];
                    v[0] *= (1.f + __expf(fminf(-bflo(gb.x), 80.f))) * frcp_(1.f + __expf(fminf(-bflo(ga.x), 80.f)));
                    v[1] *= (1.f + __expf(fminf(-bfhi(gb.x), 80.f))) * frcp_(1.f + __expf(fminf(-bfhi(ga.x), 80.f)));
                    v[2] *= (1.f + __expf(fminf(-bflo(gb.y), 80.f))) * frcp_(1.f + __expf(fminf(-bflo(ga.y), 80.f)));
                    v[3] *= (1.f + __expf(fminf(-bfhi(gb.y), 80.f))) * frcp_(1.f + __expf(fminf(-bfhi(ga.y), 80.f)));
                    acc[ai][bj][m][n] = v;
                }
#pragma unroll
            for (int bj = 0; bj < 2; ++bj)
#pragma unroll
                for (int n = 0; n < 2; ++n) { ac[bj][n] = an[bj][n]; bc[bj][n] = bn[bj][n]; }
        }
    }
    __device__ __forceinline__ void operator()(AccT& acc, const Unit& u, int wr, int wc, int fr, int fq) const {
        const int row0 = u.pm * 256 + wr * 64 + fr, col0 = u.pn * 256 + wc * 32 + 4 * fq, z = u.z;
        u32x2 gc[2][2], gn[2][2];
#pragma unroll
        for (int bj = 0; bj < 2; ++bj)
#pragma unroll
            for (int n = 0; n < 2; ++n) gc[bj][n] = *(const u32x2*)(gates + (size_t)row0 * GC + z * DM + col0 + bj * 128 + n * 16);
#pragma unroll
        for (int g = 0; g < 8; ++g) {
            const int ai = g >> 2, m = g & 3, row = row0 + ai * 128 + m * 16;
            if (g < 7) { const int row2 = row0 + ((g + 1) >> 2) * 128 + ((g + 1) & 3) * 16;
#pragma unroll
                for (int bj = 0; bj < 2; ++bj)
#pragma unroll
                    for (int n = 0; n < 2; ++n) gn[bj][n] = *(const u32x2*)(gates + (size_t)row2 * GC + z * DM + col0 + bj * 128 + n * 16); }
#pragma unroll
            for (int bj = 0; bj < 2; ++bj)
#pragma unroll
                for (int n = 0; n < 2; ++n) {
                    const int col = col0 + bj * 128 + n * 16;
                    const u32x2 gg = gc[bj][n];
                    const f32x4 v = acc[ai][bj][m][n];
                    u32x2 w; w.x = cvt_pk_bf16(v[0] * sigmoidf_(bflo(gg.x)), v[1] * sigmoidf_(bfhi(gg.x))); w.y = cvt_pk_bf16(v[2] * sigmoidf_(bflo(gg.y)), v[3] * sigmoidf_(bfhi(gg.y)));
                    *(u32x2*)(mixb + (size_t)row * DM + col) = w;
                }
#pragma unroll
            for (int bj = 0; bj < 2; ++bj)
#pragma unroll
                for (int n = 0; n < 2; ++n) gc[bj][n] = gn[bj][n];
        }
    }
};
struct EpiRes {
    static constexpr bool PERM = false; static constexpr bool ZACC = false;
    const float* xin; float* xout;
    __device__ __forceinline__ void operator()(AccT& acc, const Unit& u, int wr, int wc, int fr, int fq) const {
        const int row0 = u.pm * 256 + wr * 64 + fr, col0 = u.pn * 256 + wc * 32 + 4 * fq;
        f32x4 cur[2][2], nxt[2][2];
        { const size_t ro = (size_t)row0 * DM + col0;
#pragma unroll
          for (int bj = 0; bj < 2; ++bj)
#pragma unroll
              for (int n = 0; n < 2; ++n) cur[bj][n] = *(const f32x4*)(xin + ro + bj * 128 + n * 16); }
#pragma unroll
        for (int g = 0; g < 8; ++g) {
            const int ai = g >> 2, m = g & 3;
            if (g < 7) { const int ai2 = (g + 1) >> 2, m2 = (g + 1) & 3; const size_t ro2 = (size_t)(row0 + ai2 * 128 + m2 * 16) * DM + col0;
#pragma unroll
                for (int bj = 0; bj < 2; ++bj)
#pragma unroll
                    for (int n = 0; n < 2; ++n) nxt[bj][n] = *(const f32x4*)(xin + ro2 + bj * 128 + n * 16); }
            const size_t ro = (size_t)(row0 + ai * 128 + m * 16) * DM + col0;
#pragma unroll
            for (int bj = 0; bj < 2; ++bj)
#pragma unroll
                for (int n = 0; n < 2; ++n) *(f32x4*)(xout + ro + bj * 128 + n * 16) = acc[ai][bj][m][n] + cur[bj][n];
#pragma unroll
            for (int bj = 0; bj < 2; ++bj)
#pragma unroll
                for (int n = 0; n < 2; ++n) cur[bj][n] = nxt[bj][n];
        }
    }
};
struct EpiGU {
    static constexpr bool PERM = true; static constexpr bool ZACC = false;
    bf16_t* ffh;
    __device__ __forceinline__ void operator()(AccT& acc, const Unit& u, int wr, int wc, int fr, int fq) const {
        const int row0 = u.pm * 256 + wr * 64 + fr, col0 = u.pn * 128 + wc * 32 + 8 * fq;
#pragma unroll
        for (int ai = 0; ai < 2; ++ai)
#pragma unroll
            for (int m = 0; m < 4; ++m) {
                f32x4 h0 = acc[ai][0][m][0], h1 = acc[ai][0][m][1]; const f32x4 u0 = acc[ai][1][m][0], u1 = acc[ai][1][m][1];
#pragma unroll
                for (int j = 0; j < 4; ++j) { h0[j] = siluf_(h0[j]) * u0[j]; h1[j] = siluf_(h1[j]) * u1[j]; }
                u32x4 w; w.x = cvt_pk_bf16(h0[0], h0[1]); w.y = cvt_pk_bf16(h0[2], h0[3]); w.z = cvt_pk_bf16(h1[0], h1[1]); w.w = cvt_pk_bf16(h1[2], h1[3]);
                *(u32x4*)(ffh + (size_t)(row0 + ai * 128 + m * 16) * FH + col0) = w;
            }
    }
};

__device__ __forceinline__ void transpose_item(const float* W, int K, int N, bf16_t* WT, int grp_shift, int gmul, int goff, float* scr, int item, int lane) {
    const int nblk = N / 32, kb = item / nblk, nb = item - kb * nblk, k0 = 64 * kb, n0 = 32 * nb;
    float wv[32];
    { const float* wp = W + (size_t)(k0 + (lane >> 5)) * N + n0 + (lane & 31);
#pragma unroll
      for (int i = 0; i < 32; ++i) wv[i] = __builtin_nontemporal_load(wp + (size_t)(2 * i) * N); }
#pragma unroll
    for (int i = 0; i < 32; ++i) scr[(2 * i + (lane >> 5)) * 33 + (lane & 31)] = wv[i];
    __builtin_amdgcn_wave_barrier();
    const int c = lane & 7;
#pragma unroll
    for (int j = 0; j < 4; ++j) { const int n = (lane >> 3) + 8 * j; const float* s = scr + (8 * c) * 33 + n;
        u32x4 o; o.x = cvt_pk_bf16(s[0 * 33], s[1 * 33]); o.y = cvt_pk_bf16(s[2 * 33], s[3 * 33]); o.z = cvt_pk_bf16(s[4 * 33], s[5 * 33]); o.w = cvt_pk_bf16(s[6 * 33], s[7 * 33]);
        const int ng = n0 + n; const int drow = grp_shift >= 0 ? (((ng >> grp_shift) * gmul) + goff + (ng & ((1 << grp_shift) - 1))) : ng;
        *(u32x4*)(WT + (size_t)drow * K + k0 + 8 * c) = o; }
    __builtin_amdgcn_wave_barrier();
}

__device__ __forceinline__ void rmsnorm_rows_bf16(const float* x, const float* g, bf16_t* o, int gw, int ngw, int lane) {
    for (int r = gw; r < NTOK; r += 2 * ngw) {
        const int r2 = r + ngw;
        const f32x4* xa = (const f32x4*)(x + (size_t)r * DM) + lane; const f32x4* xb = (const f32x4*)(x + (size_t)r2 * DM) + lane;
        f32x4 va[8], vb[8]; float sa = 0.f, sb = 0.f;
#pragma unroll
        for (int j = 0; j < 8; ++j) { va[j] = xa[64 * j]; vb[j] = xb[64 * j]; }
#pragma unroll
        for (int j = 0; j < 8; ++j) { sa += (va[j].x * va[j].x + va[j].y * va[j].y) + (va[j].z * va[j].z + va[j].w * va[j].w); sb += (vb[j].x * vb[j].x + vb[j].y * vb[j].y) + (vb[j].z * vb[j].z + vb[j].w * vb[j].w); }
#pragma unroll
        for (int o2 = 1; o2 < 64; o2 <<= 1) { sa += __shfl_xor(sa, o2); sb += __shfl_xor(sb, o2); }
        const float ra = 1.f / sqrtf(sa * (1.f / DM) + EPS), rb = 1.f / sqrtf(sb * (1.f / DM) + EPS);
        u32x2* oa = (u32x2*)(o + (size_t)r * DM) + lane; u32x2* ob = (u32x2*)(o + (size_t)r2 * DM) + lane;
#pragma unroll
        for (int j = 0; j < 8; ++j) { const f32x4 gg = *((const f32x4*)g + lane + 64 * j);
            u32x2 w; w.x = cvt_pk_bf16(va[j].x * ra * gg.x, va[j].y * ra * gg.y); w.y = cvt_pk_bf16(va[j].z * ra * gg.z, va[j].w * ra * gg.w); oa[64 * j] = w;
            u32x2 w2; w2.x = cvt_pk_bf16(vb[j].x * rb * gg.x, vb[j].y * rb * gg.y); w2.y = cvt_pk_bf16(vb[j].z * rb * gg.z, vb[j].w * rb * gg.w); ob[64 * j] = w2; }
    }
}

__device__ __forceinline__ void rope_entry(double base_log2, int rot, int i, int pos, float& co, float& si) {
    const double inv = exp2(-(2.0 * i / rot) * base_log2);
    const double ang = (double)pos * inv;
    const double TWO_PI = 6.283185307179586476925286766559;
    const double k = rint(ang / TWO_PI);
    const double r = fma(-k, 2.4492935982947064e-16, fma(-k, TWO_PI, ang));
    const double r2 = r * r;
    double ts = r, ss = r, tc = 1.0, sc = 1.0;
#pragma unroll
    for (int n = 1; n <= 14; ++n) { ts *= -r2 / (double)((2 * n) * (2 * n + 1)); ss += ts; tc *= -r2 / (double)((2 * n - 1) * (2 * n)); sc += tc; }
    co = (float)sc; si = (float)ss;
}

__device__ __forceinline__ void prep_phase(const Params& p, int layer, unsigned char* lds, const float* xin, const float* gain) {
    const int tid = tid_fresh(), wave = tid >> 6, lane = tid & 63;
    const int G = gridDim.x, gw = blockIdx.x * 8 + wave, ngw = G * 8;
    float* scr = (float*)(lds + wave * 16384);
    unsigned char* ws = p.ws;
    if (layer == 0) {
        if (blockIdx.x == 0) { if (tid < 64) ((unsigned*)(ws + WS_CTR))[tid] = 0u; for (int e = tid; e < 3456; e += 512) ((unsigned*)(ws + WS_XBAR))[e] = 0u; }
        float* rr = (float*)(ws + WS_ROPER); float* rm = (float*)(ws + WS_ROPEM);
        const int gt = blockIdx.x * 512 + tid, ngt = G * 512;
        for (int e = gt; e < SEQ * 128; e += ngt) { const int pos = e >> 7, i = e & 127; float c, s; rope_entry(13.287712379549449, 256, i, pos, c, s); rr[e] = c; rr[SEQ * 128 + e] = s; }
        for (int e = gt; e < SEQ * 16; e += ngt) { const int pos = e >> 4, i = e & 15; float c, s; rope_entry(18.931568569324174, 32, i, pos, c, s); rm[e] = c; rm[SEQ * 16 + e] = s; }
    }
    constexpr int I_IN = (DM / 64) * (INC / 32), I_BR = (1024 / 64) * (DM / 32), I_OUT = (DM / 64) * (DM / 32), I_G = (DM / 64) * (FH / 32), I_DN = (FH / 64) * (DM / 32);
    constexpr int NITEMS = I_IN + 3 * I_BR + I_OUT + 2 * I_G + I_DN;
    for (int it = gw; it < NITEMS; it += ngw) {
        int r = it;
        if (r < I_IN) { transpose_item(p.w_in + (size_t)layer * E_WIN, DM, INC, (bf16_t*)(ws + WS_WIN), -1, 0, 0, scr, r, lane); continue; } r -= I_IN;
        if (r < 3 * I_BR) { const int b = r / I_BR; transpose_item(p.w_br[b] + (size_t)layer * E_WBR, 1024, DM, (bf16_t*)(ws + WS_WBR) + (size_t)b * E_WBR, -1, 0, 0, scr, r - b * I_BR, lane); continue; } r -= 3 * I_BR;
        if (r < I_OUT) { transpose_item(p.w_out + (size_t)layer * E_WOUT, DM, DM, (bf16_t*)(ws + WS_WOUT), -1, 0, 0, scr, r, lane); continue; } r -= I_OUT;
        if (r < I_G) { transpose_item(p.w_gate + (size_t)layer * DM * FH, DM, FH, (bf16_t*)(ws + WS_WGU), 7, 256, 0, scr, r, lane); continue; } r -= I_G;
        if (r < I_G) { transpose_item(p.w_up + (size_t)layer * DM * FH, DM, FH, (bf16_t*)(ws + WS_WGU), 7, 256, 128, scr, r, lane); continue; } r -= I_G;
        transpose_item(p.w_down + (size_t)layer * E_WDN, FH, DM, (bf16_t*)(ws + WS_WDN), -1, 0, 0, scr, r, lane);
    }
    rmsnorm_rows_bf16(xin, gain, (bf16_t*)(ws + WS_HB), gw, ngw, lane);
}

template <bool SWAP>
__device__ __forceinline__ f32x4 mma_tile(const bf16_t* A, int lda, const bf16_t* B, int ldb, int ksteps, f32x4 acc, int lane) {
    const bf16_t* ap = A + (lane & 15) * lda + (lane >> 4) * 8;
    const bf16_t* bp = B + (lane & 15) * ldb + (lane >> 4) * 8;
    for (int ks = 0; ks < ksteps; ++ks) {
        const bf16x8 a = *(const bf16x8*)(ap + ks * 32), b = *(const bf16x8*)(bp + ks * 32);
        acc = SWAP ? __builtin_amdgcn_mfma_f32_16x16x32_bf16(b, a, acc, 0, 0, 0) : __builtin_amdgcn_mfma_f32_16x16x32_bf16(a, b, acc, 0, 0, 0);
    }
    return acc;
}
__device__ __forceinline__ void stage_copy(const bf16_t* src, int ld, int nrows, int ncols, bf16_t* dst, int lds_ld, int tid) {
    const int cgs = ncols >> 3, total = nrows * cgs;
    for (int idx = tid; idx < total; idx += 512) { const int r = idx / cgs, c = idx - r * cgs;
        *(u32x4*)(dst + r * lds_ld + c * 8) = *(const u32x4*)(src + (size_t)r * ld + c * 8); }
}
template <class F>
__device__ __forceinline__ void stage_T(const bf16_t* src, int ld, int nrows, int ncols, bf16_t* dst, int lds_ld, int tid, F f) {
    const int cgs = ncols >> 3, total = (nrows >> 1) * cgs;
    for (int idx = tid; idx < total; idx += 512) { const int rp = idx / cgs, c = idx - rp * cgs;
        const u32x4 a = *(const u32x4*)(src + (size_t)(2 * rp) * ld + c * 8), b = *(const u32x4*)(src + (size_t)(2 * rp + 1) * ld + c * 8);
        const unsigned aw[4] = {a.x, a.y, a.z, a.w}, bw[4] = {b.x, b.y, b.z, b.w};
#pragma unroll
        for (int i = 0; i < 4; ++i) {
            const int cc = c * 8 + 2 * i;
            *(unsigned*)(dst + (cc) * lds_ld + 2 * rp) = cvt_pk_bf16(f(bflo(aw[i]), 2 * rp, cc), f(bflo(bw[i]), 2 * rp + 1, cc));
            *(unsigned*)(dst + (cc + 1) * lds_ld + 2 * rp) = cvt_pk_bf16(f(bfhi(aw[i]), 2 * rp, cc + 1), f(bfhi(bw[i]), 2 * rp + 1, cc + 1));
        }
    }
}
__device__ __forceinline__ float ret_log2_gamma(int h) { return log2f(1.f - exp2f(-5.f - (float)h)); }
__device__ __forceinline__ float hgrn_lower(const float* lb, int layer, int c) {
    if (layer == 0) return 0.f;
    return 1.f / (1.f + __expf(lb[c] - lb[1024 + c]));
}

typedef short s16x4 __attribute__((ext_vector_type(4)));
__device__ __forceinline__ bf16x8 tr_frag_perm(LAS unsigned char* base, int row0, int col0, int ld, int fr, int fq) {
    const int off = ((row0 + fq * 4 + (fr >> 2)) * ld + col0 + (fr & 3) * 4) * 2;
    const s16x4 lo = __builtin_amdgcn_ds_read_tr16_b64_v4i16((LAS s16x4*)(base + off));
    const s16x4 hi = __builtin_amdgcn_ds_read_tr16_b64_v4i16((LAS s16x4*)(base + off + 16 * ld * 2));
    return __builtin_shufflevector(lo, hi, 0, 1, 2, 3, 4, 5, 6, 7);
}
__device__ __forceinline__ bf16x8 row_frag_perm(const bf16_t* M, int ld, int r0, int k0, int fr, int fq) {
    const bf16_t* q = M + (r0 + fr) * ld + k0 + fq * 4;
    const u32x2 lo = *(const u32x2*)q, hi = *(const u32x2*)(q + 16);
    u32x4 w; w.x = lo.x; w.y = lo.y; w.z = hi.x; w.w = hi.y; return __builtin_bit_cast(bf16x8, w);
}
__device__ __forceinline__ void m1_ret(const Params& p, unsigned char* lds, int item) {
    const int tid = tid_fresh(), wave = tid >> 6, lane = tid & 63, fr = lane & 15, fq = lane >> 4;
    const int bh = item >> 5, n = item & 31, b = bh >> 2, h = bh & 3;
    const bf16_t* projA = (const bf16_t*)(p.ws + WS_PROJA);
    const size_t t0 = (size_t)b * SEQ + n * 128;
    bf16_t* Vs = (bf16_t*)lds; bf16_t* Ks = (bf16_t*)(lds + 128 * 272 * 2);
    const float l2g = ret_log2_gamma(h);
    {
        const int r0 = tid >> 5, c0 = tid & 31;
        u32x4 vv[8], kv[8];
#pragma unroll
        for (int i = 0; i < 8; ++i) { vv[i] = *(const u32x4*)(projA + (t0 + r0 + 16 * i) * PA + C_RV + h * 256 + c0 * 8); kv[i] = *(const u32x4*)(projA + (t0 + r0 + 16 * i) * PA + C_RK + h * 256 + c0 * 8); }
#pragma unroll
        for (int i = 0; i < 8; ++i) { const int r = r0 + 16 * i; const float sc = exp2f(l2g * (float)(127 - r));
            *(u32x4*)(Vs + r * 272 + c0 * 8) = vv[i];
            u32x4 w; w.x = cvt_pk_bf16(bflo(kv[i].x) * sc, bfhi(kv[i].x) * sc); w.y = cvt_pk_bf16(bflo(kv[i].y) * sc, bfhi(kv[i].y) * sc);
            w.z = cvt_pk_bf16(bflo(kv[i].z) * sc, bfhi(kv[i].z) * sc); w.w = cvt_pk_bf16(bflo(kv[i].w) * sc, bfhi(kv[i].w) * sc);
            *(u32x4*)(Ks + r * 272 + c0 * 8) = w; }
    }
    __syncthreads();
    const int we = wave >> 2, wd = wave & 3;
    bf16_t* st = (bf16_t*)(p.ws + WS_STR) + (size_t)item * 65536;
    LAS unsigned char* l3 = (LAS unsigned char*)lds;
    bf16x8 bfr[4][4];
#pragma unroll
    for (int dt = 0; dt < 4; ++dt)
#pragma unroll
        for (int ks = 0; ks < 4; ++ks) bfr[dt][ks] = tr_frag_perm(l3 + 128 * 272 * 2, ks * 32, wd * 64 + dt * 16, 272, fr, fq);
    for (int et = 0; et < 8; ++et) {
        bf16x8 afr[4];
#pragma unroll
        for (int ks = 0; ks < 4; ++ks) afr[ks] = tr_frag_perm(l3, ks * 32, we * 128 + et * 16, 272, fr, fq);
        const int e = we * 128 + et * 16 + fr;
#pragma unroll
        for (int dt = 0; dt < 4; ++dt) {
            f32x4 acc = (f32x4){0.f, 0.f, 0.f, 0.f};
#pragma unroll
            for (int ks = 0; ks < 4; ++ks) acc = __builtin_amdgcn_mfma_f32_16x16x32_bf16(bfr[dt][ks], afr[ks], acc, 0, 0, 0);
            const int d = wd * 64 + dt * 16 + fq * 4;
            u32x2 w; w.x = cvt_pk_bf16(acc[0], acc[1]); w.y = cvt_pk_bf16(acc[2], acc[3]); *(u32x2*)(st + e * 256 + d) = w;
        }
    }
    __syncthreads();
}

__device__ __forceinline__ void hgrn_gates2(const Params& p, int layer, const bf16_t* projA, size_t t0, int h, int dp, int tg, float (&kk)[8][2], float (&bcl)[8][2]) {
    const float lb0 = hgrn_lower(p.lb, layer, h * 128 + 2 * dp), lb1 = hgrn_lower(p.lb, layer, h * 128 + 2 * dp + 1);
    const bf16_t* src = projA + (t0 + tg * 8) * PA + C_HF + h * 128 + 2 * dp;
    unsigned hw[8];
#pragma unroll
    for (int jj = 0; jj < 8; ++jj) hw[jj] = *(const unsigned*)(src + (size_t)jj * PA);
    float r0 = 0.f, r1 = 0.f;
#pragma unroll
    for (int jj = 0; jj < 8; ++jj) {
        const float s0 = frcp_(1.f + __expf(-bflo(hw[jj]))), s1 = frcp_(1.f + __expf(-bfhi(hw[jj])));
        const float k0 = (1.f - lb0) * (1.f - s0), k1 = (1.f - lb1) * (1.f - s1);
        kk[jj][0] = k0; kk[jj][1] = k1;
        r0 += __logf(fmaxf(1.f - k0, 1e-30f)); r1 += __logf(fmaxf(1.f - k1, 1e-30f));
        bcl[jj][0] = r0; bcl[jj][1] = r1;
    }
}

__device__ __forceinline__ void m1_hgrn(const Params& p, int layer, unsigned char* lds, int item) {
    const int tid = tid_fresh(), wave = tid >> 6, lane = tid & 63, fr = lane & 15, fq = lane >> 4;
    const int bh = item >> 6, n = item & 63, b = bh >> 3, h = bh & 7;
    const bf16_t* projA = (const bf16_t*)(p.ws + WS_PROJA);
    const size_t t0 = (size_t)b * SEQ + n * 64;
    float* TOT = (float*)lds;
    bf16_t* Vs = (bf16_t*)(lds + 4096);
    bf16_t* Kd = (bf16_t*)(lds + 4096 + 18432);
    const int dp = tid & 63, tg = tid >> 6;
    const int vr = tid >> 4, vc = tid & 15;
    const u32x4 v0 = *(const u32x4*)(projA + (t0 + vr) * PA + C_HI + h * 128 + vc * 8), v1 = *(const u32x4*)(projA + (t0 + vr + 32) * PA + C_HI + h * 128 + vc * 8);
    float kk[8][2], bcl[8][2];
    hgrn_gates2(p, layer, projA, t0, h, dp, tg, kk, bcl);
    TOT[tg * 128 + 2 * dp] = bcl[7][0]; TOT[tg * 128 + 2 * dp + 1] = bcl[7][1];
    *(u32x4*)(Vs + vr * 144 + vc * 8) = v0; *(u32x4*)(Vs + (vr + 32) * 144 + vc * 8) = v1;
    __syncthreads();
    {
        float t0s = 0.f, t1s = 0.f;
        for (int g = 7; g > tg; --g) { t0s += TOT[g * 128 + 2 * dp]; t1s += TOT[g * 128 + 2 * dp + 1]; }
        const float tot0 = bcl[7][0] + t0s, tot1 = bcl[7][1] + t1s;
#pragma unroll
        for (int jj = 0; jj < 8; ++jj)
            *(unsigned*)(Kd + (tg * 8 + jj) * 144 + 2 * dp) = cvt_pk_bf16(kk[jj][0] * __expf(tot0 - bcl[jj][0]), kk[jj][1] * __expf(tot1 - bcl[jj][1]));
        if (tg == 0) { float* hd = (float*)(p.ws + WS_HDEC) + (size_t)item * 128 + 2 * dp; hd[0] = __expf(tot0); hd[1] = __expf(tot1); }
    }
    __syncthreads();
    const int we = wave >> 2, wd = wave & 3;
    bf16_t* st = (bf16_t*)(p.ws + WS_STH) + (size_t)item * 16384;
    LAS unsigned char* l3 = (LAS unsigned char*)lds;
    bf16x8 bfr[2][2];
#pragma unroll
    for (int dt = 0; dt < 2; ++dt)
#pragma unroll
        for (int ks = 0; ks < 2; ++ks) bfr[dt][ks] = tr_frag_perm(l3 + 4096 + 18432, ks * 32, wd * 32 + dt * 16, 144, fr, fq);
#pragma unroll
    for (int et = 0; et < 4; ++et) {
        bf16x8 afr[2];
#pragma unroll
        for (int ks = 0; ks < 2; ++ks) afr[ks] = tr_frag_perm(l3 + 4096, ks * 32, we * 64 + et * 16, 144, fr, fq);
#pragma unroll
        for (int dt = 0; dt < 2; ++dt) {
            f32x4 acc = (f32x4){0.f, 0.f, 0.f, 0.f};
#pragma unroll
            for (int ks = 0; ks < 2; ++ks) acc = __builtin_amdgcn_mfma_f32_16x16x32_bf16(bfr[dt][ks], afr[ks], acc, 0, 0, 0);
            const int e = we * 64 + et * 16 + fr, dd = wd * 32 + dt * 16 + fq * 4;
            u32x2 w; w.x = cvt_pk_bf16(acc[0], acc[1]); w.y = cvt_pk_bf16(acc[2], acc[3]); *(u32x2*)(st + e * 128 + dd) = w;
        }
    }
    __syncthreads();
}

__device__ __forceinline__ void m1_kmean(const Params& p, unsigned char* lds, int item) {
    const int tid = tid_fresh();
    const int bh = item >> 4, blk = item & 15, b = bh >> 3, h = bh & 7;
    const bf16_t* projA = (const bf16_t*)(p.ws + WS_PROJA);
    const size_t t0 = (size_t)b * SEQ + blk * 256;
    const int c = tid & 15, rg = tid >> 4;
    u32x4 kv[8];
#pragma unroll
    for (int i = 0; i < 8; ++i) kv[i] = *(const u32x4*)(projA + (t0 + rg + 32 * i) * PA + C_MK + h * 128 + c * 8);
    float s[8] = {0.f, 0.f, 0.f, 0.f, 0.f, 0.f, 0.f, 0.f};
#pragma unroll
    for (int i = 0; i < 8; ++i) { s[0] += bflo(kv[i].x); s[1] += bfhi(kv[i].x); s[2] += bflo(kv[i].y); s[3] += bfhi(kv[i].y); s[4] += bflo(kv[i].z); s[5] += bfhi(kv[i].z); s[6] += bflo(kv[i].w); s[7] += bfhi(kv[i].w); }
    float* red = (float*)lds;
#pragma unroll
    for (int j = 0; j < 8; ++j) red[rg * 128 + c * 8 + j] = s[j];
    __syncthreads();
    if (tid < 128) { float t = 0.f;
#pragma unroll 8
        for (int r = 0; r < 32; ++r) t += red[r * 128 + tid];
        ((float*)(p.ws + WS_KMEAN))[(size_t)item * 128 + tid] = t * (1.f / 256.f); }
    __syncthreads();
}

__device__ __forceinline__ void m1_phase(const Params& p, int layer, unsigned char* lds) {
    for (int it = blockIdx.x; it < 512 + 2048 + 512; it += gridDim.x) {
        if (it < 512) m1_ret(p, lds, it);
        else if (it < 2560) m1_hgrn(p, layer, lds, it - 512);
        else m1_kmean(p, lds, it - 2560);
    }
}

__device__ __forceinline__ void m2_phase(const Params& p) {
    const int gt = blockIdx.x * 512 + tid_fresh(), ngt = gridDim.x * 512;
    for (int idx = gt; idx < 16 * 8192; idx += ngt) {
        const int bh = idx >> 13, off = (idx & 8191) * 8, h = bh & 3;
        const float cd = exp2f(ret_log2_gamma(h) * 128.f);
        bf16_t* base = (bf16_t*)(p.ws + WS_STR) + (size_t)bh * 32 * 65536 + off;
        float st[8];
#pragma unroll
        for (int i = 0; i < 8; ++i) st[i] = 0.f;
        for (int n0 = 0; n0 < 32; n0 += 8) {
            u32x4 kv[8];
#pragma unroll
            for (int j = 0; j < 8; ++j) kv[j] = *(const u32x4*)(base + (size_t)(n0 + j) * 65536);
#pragma unroll
            for (int j = 0; j < 8; ++j) {
                u32x4 o; o.x = cvt_pk_bf16(st[0], st[1]); o.y = cvt_pk_bf16(st[2], st[3]); o.z = cvt_pk_bf16(st[4], st[5]); o.w = cvt_pk_bf16(st[6], st[7]);
                *(u32x4*)(base + (size_t)(n0 + j) * 65536) = o;
                st[0] = cd * st[0] + bflo(kv[j].x); st[1] = cd * st[1] + bfhi(kv[j].x); st[2] = cd * st[2] + bflo(kv[j].y); st[3] = cd * st[3] + bfhi(kv[j].y);
                st[4] = cd * st[4] + bflo(kv[j].z); st[5] = cd * st[5] + bfhi(kv[j].z); st[6] = cd * st[6] + bflo(kv[j].w); st[7] = cd * st[7] + bfhi(kv[j].w);
            }
        }
    }
    for (int idx = gt; idx < 32 * 4096; idx += ngt) {
        const int bh = idx >> 12, off = (idx & 4095) * 4, d = off & 127;
        bf16_t* base = (bf16_t*)(p.ws + WS_STH) + (size_t)bh * 64 * 16384 + off;
        const float* dec = (const float*)(p.ws + WS_HDEC) + (size_t)bh * 64 * 128 + d;
        float st[4] = {0.f, 0.f, 0.f, 0.f};
        for (int n0 = 0; n0 < 64; n0 += 8) {
            u32x2 kv[8]; f32x4 dc[8];
#pragma unroll
            for (int j = 0; j < 8; ++j) { kv[j] = *(const u32x2*)(base + (size_t)(n0 + j) * 16384); dc[j] = *(const f32x4*)(dec + (n0 + j) * 128); }
#pragma unroll
            for (int j = 0; j < 8; ++j) {
                u32x2 o; o.x = cvt_pk_bf16(st[0], st[1]); o.y = cvt_pk_bf16(st[2], st[3]);
                *(u32x2*)(base + (size_t)(n0 + j) * 16384) = o;
                st[0] = dc[j].x * st[0] + bflo(kv[j].x); st[1] = dc[j].y * st[1] + bfhi(kv[j].x); st[2] = dc[j].z * st[2] + bflo(kv[j].y); st[3] = dc[j].w * st[3] + bfhi(kv[j].y);
            }
        }
    }
}

__device__ __forceinline__ void m3_ret(const Params& p, int layer, unsigned char* lds, int item) {
    const int tid = tid_fresh(), wave = tid >> 6, lane = tid & 63, fr = lane & 15, fq = lane >> 4;
    const int bh = item >> 5, n = item & 31, b = bh >> 2, h = bh & 3;
    const bf16_t* projA = (const bf16_t*)(p.ws + WS_PROJA);
    const size_t t0 = (size_t)b * SEQ + n * 128;
    bf16_t* R2 = (bf16_t*)lds;
    bf16_t* Ps = (bf16_t*)(lds + 69632);
    float* ST = (float*)(lds + 69632 + 34816);
    const float l2g = ret_log2_gamma(h);
    const int wi = wave >> 1, wc = wave & 1;
    const int cr = tid >> 5, cc = tid & 31;
    bf16x8 qf[2][8];
#pragma unroll
    for (int it = 0; it < 2; ++it)
#pragma unroll
        for (int ks = 0; ks < 8; ++ks) qf[it][ks] = *(const bf16x8*)(projA + (t0 + wi * 32 + it * 16 + fr) * PA + C_RQ + h * 256 + ks * 32 + fq * 8);
    u32x4 rr[8];
#pragma unroll
    for (int i = 0; i < 8; ++i) rr[i] = *(const u32x4*)(projA + (t0 + cr + 16 * i) * PA + C_RK + h * 256 + cc * 8);
#pragma unroll
    for (int i = 0; i < 8; ++i) *(u32x4*)(R2 + (cr + 16 * i) * 264 + cc * 8) = rr[i];
    const bf16_t* stg = (const bf16_t*)(p.ws + WS_STR) + (size_t)item * 65536;
#pragma unroll
    for (int i = 0; i < 8; ++i) rr[i] = *(const u32x4*)(stg + (size_t)(cr + 16 * i) * 256 + cc * 8);
    __syncthreads();
#pragma unroll
    for (int it = 0; it < 2; ++it)
#pragma unroll
        for (int jt = 0; jt < 4; ++jt) {
            const int jb = wc * 64 + jt * 16, ib = wi * 32 + it * 16;
            f32x4 a = (f32x4){0.f, 0.f, 0.f, 0.f};
            if (jb <= ib + 15) {
#pragma unroll
                for (int ks = 0; ks < 8; ++ks) { const bf16x8 kf = *(const bf16x8*)(R2 + (jb + fr) * 264 + ks * 32 + fq * 8);
                    a = __builtin_amdgcn_mfma_f32_16x16x32_bf16(kf, qf[it][ks], a, 0, 0, 0); }
            }
            const int i = ib + fr, j0 = jb + fq * 4;
            float pv[4];
#pragma unroll
            for (int jj = 0; jj < 4; ++jj) { const int rel = i - (j0 + jj); pv[jj] = rel >= 0 ? a[jj] * exp2f(l2g * (float)rel) : 0.f; }
            u32x2 w; w.x = cvt_pk_bf16(pv[0], pv[1]); w.y = cvt_pk_bf16(pv[2], pv[3]); *(u32x2*)(Ps + i * 136 + j0) = w;
        }
    __syncthreads();
    f32x4 acc[2][2][4];
#pragma unroll
    for (int a = 0; a < 2; ++a)
#pragma unroll
        for (int e = 0; e < 2; ++e)
#pragma unroll
            for (int t = 0; t < 4; ++t) acc[a][e][t] = (f32x4){0.f, 0.f, 0.f, 0.f};
#pragma unroll
    for (int eh = 0; eh < 2; ++eh) {
#pragma unroll
        for (int i = 0; i < 8; ++i) *(u32x4*)(R2 + (cr + 16 * i) * 264 + cc * 8) = rr[i];
        if (eh == 0) {
#pragma unroll
            for (int i = 0; i < 8; ++i) rr[i] = *(const u32x4*)(stg + (size_t)(128 + cr + 16 * i) * 256 + cc * 8);
        } else {
#pragma unroll
            for (int i = 0; i < 8; ++i) rr[i] = *(const u32x4*)(projA + (t0 + cr + 16 * i) * PA + C_RV + h * 256 + cc * 8);
        }
        __syncthreads();
#pragma unroll
        for (int e4 = 0; e4 < 4; ++e4)
#pragma unroll
            for (int ks = 0; ks < 8; ++ks) { const bf16x8 rf = *(const bf16x8*)(R2 + (wc * 64 + e4 * 16 + fr) * 264 + ks * 32 + fq * 8);
#pragma unroll
                for (int it = 0; it < 2; ++it) acc[it][eh][e4] = __builtin_amdgcn_mfma_f32_16x16x32_bf16(rf, qf[it][ks], acc[it][eh][e4], 0, 0, 0); }
        __syncthreads();
    }
#pragma unroll
    for (int it = 0; it < 2; ++it) { const float sc = exp2f(l2g * (float)(wi * 32 + it * 16 + fr + 1));
#pragma unroll
        for (int e = 0; e < 2; ++e)
#pragma unroll
            for (int t = 0; t < 4; ++t) acc[it][e][t] *= sc; }
#pragma unroll
    for (int i = 0; i < 8; ++i) *(u32x4*)(R2 + (cr + 16 * i) * 272 + cc * 8) = rr[i];
    __syncthreads();
    {
        LAS unsigned char* l3 = (LAS unsigned char*)lds;
#pragma unroll
        for (int ks = 0; ks < 4; ++ks) {
            bf16x8 pa[2];
#pragma unroll
            for (int it = 0; it < 2; ++it) pa[it] = row_frag_perm(Ps, 136, wi * 32 + it * 16, ks * 32, fr, fq);
#pragma unroll
            for (int eh = 0; eh < 2; ++eh)
#pragma unroll
                for (int e4 = 0; e4 < 4; ++e4) { const bf16x8 vb = tr_frag_perm(l3, ks * 32, eh * 128 + wc * 64 + e4 * 16, 272, fr, fq);
#pragma unroll
                    for (int it = 0; it < 2; ++it) acc[it][eh][e4] = __builtin_amdgcn_mfma_f32_16x16x32_bf16(vb, pa[it], acc[it][eh][e4], 0, 0, 0); }
        }
    }
#pragma unroll
    for (int it = 0; it < 2; ++it) {
        float s = 0.f, s2 = 0.f;
#pragma unroll
        for (int e = 0; e < 2; ++e)
#pragma unroll
            for (int t = 0; t < 4; ++t)
#pragma unroll
                for (int j = 0; j < 4; ++j) { const float v = acc[it][e][t][j]; s += v; s2 += v * v; }
        s += __shfl_xor(s, 16); s += __shfl_xor(s, 32); s2 += __shfl_xor(s2, 16); s2 += __shfl_xor(s2, 32);
        if (fq == 0) { ST[((wi * 32 + it * 16 + fr) * 2 + wc) * 2] = s; ST[((wi * 32 + it * 16 + fr) * 2 + wc) * 2 + 1] = s2; }
    }
    __syncthreads();
    bf16_t* ro = (bf16_t*)(p.ws + WS_BOUT);
    const float* rn = p.ret_norm + (size_t)layer * 1024 + h * 256;
#pragma unroll
    for (int it = 0; it < 2; ++it) {
        const int i = wi * 32 + it * 16 + fr;
        const float s = ST[i * 4] + ST[i * 4 + 2], s2 = ST[i * 4 + 1] + ST[i * 4 + 3];
        const float mu = s * (1.f / 256.f), var = fmaxf(s2 * (1.f / 256.f) - mu * mu, 0.f), rstd = __builtin_amdgcn_rsqf(var + EPS);
        const size_t tok = t0 + i;
#pragma unroll
        for (int eh = 0; eh < 2; ++eh)
#pragma unroll
            for (int e4 = 0; e4 < 4; ++e4) {
                const int e = eh * 128 + wc * 64 + e4 * 16 + fq * 4;
                const u32x2 g = *(const u32x2*)(projA + tok * PA + C_RG + h * 256 + e);
                const f32x4 nn = *(const f32x4*)(rn + e);
                const f32x4 v = acc[it][eh][e4];
                const float o0 = (v[0] - mu) * rstd * nn[0] * siluf_(bflo(g.x)), o1 = (v[1] - mu) * rstd * nn[1] * siluf_(bfhi(g.x));
                const float o2 = (v[2] - mu) * rstd * nn[2] * siluf_(bflo(g.y)), o3 = (v[3] - mu) * rstd * nn[3] * siluf_(bfhi(g.y));
                u32x2 w; w.x = cvt_pk_bf16(o0, o1); w.y = cvt_pk_bf16(o2, o3);
                *(u32x2*)(ro + tok * 1024 + h * 256 + e) = w;
            }
    }
    __syncthreads();
}

__device__ __forceinline__ void m3_hgrn(const Params& p, int layer, unsigned char* lds, int item) {
    const int tid = tid_fresh(), wave = tid >> 6, lane = tid & 63, fr = lane & 15, fq = lane >> 4;
    const int bh = item >> 6, n = item & 63, b = bh >> 3, h = bh & 7;
    const bf16_t* projA = (const bf16_t*)(p.ws + WS_PROJA);
    const size_t t0 = (size_t)b * SEQ + n * 64;
    float* TOT = (float*)lds;
    bf16_t* Qb = (bf16_t*)(lds + 4096);
    bf16_t* Qe = (bf16_t*)(lds + 21504);
    bf16_t* Ke = (bf16_t*)(lds + 38912);
    bf16_t* Ss = (bf16_t*)(lds + 82432);
    bf16_t* Vs = (bf16_t*)(lds + 117248);
    bf16_t* Ps = (bf16_t*)(lds + 135680);
    float* ST = (float*)(lds + 144896);
    const int dp = tid & 63, tg = tid >> 6;
    const int vr = tid >> 4, vc = tid & 15;
    const u32x4 v0 = *(const u32x4*)(projA + (t0 + vr) * PA + C_HI + h * 128 + vc * 8), v1 = *(const u32x4*)(projA + (t0 + vr + 32) * PA + C_HI + h * 128 + vc * 8);
    const bf16_t* sgl = (const bf16_t*)(p.ws + WS_STH) + (size_t)item * 16384;
    u32x4 sv[4];
#pragma unroll
    for (int i = 0; i < 4; ++i) sv[i] = *(const u32x4*)(sgl + (vr + 32 * i) * 128 + vc * 8);
    unsigned qw[8];
    { const bf16_t* src = projA + (t0 + tg * 8) * PA + C_HQ + h * 128 + 2 * dp;
#pragma unroll
      for (int jj = 0; jj < 8; ++jj) qw[jj] = *(const unsigned*)(src + (size_t)jj * PA); }
    float kk[8][2], bcl[8][2];
    hgrn_gates2(p, layer, projA, t0, h, dp, tg, kk, bcl);
    TOT[tg * 128 + 2 * dp] = bcl[7][0]; TOT[tg * 128 + 2 * dp + 1] = bcl[7][1];
    *(u32x4*)(Vs + vr * 144 + vc * 8) = v0; *(u32x4*)(Vs + (vr + 32) * 144 + vc * 8) = v1;
#pragma unroll
    for (int i = 0; i < 4; ++i) *(u32x4*)(Ss + (vr + 32 * i) * 136 + vc * 8) = sv[i];
    __syncthreads();
    {
        const int I = tg >> 1;
        const float* T0 = TOT + 2 * dp;
        float B0 = 0.f, B1 = 0.f;
        for (int g = 0; g < 2 * I; ++g) { B0 += T0[g * 128]; B1 += T0[g * 128 + 1]; }
        const float o0 = (tg & 1) ? T0[(2 * I) * 128] : 0.f, o1 = (tg & 1) ? T0[(2 * I) * 128 + 1] : 0.f;
        float ra0 = 0.f, ra1 = 0.f, rb0 = 0.f, rb1 = 0.f, rc0 = 0.f, rc1 = 0.f;
        if (I < 3) { ra0 = T0[(2 * I) * 128] + T0[(2 * I + 1) * 128]; ra1 = T0[(2 * I) * 128 + 1] + T0[(2 * I + 1) * 128 + 1]; }
        if (I < 2) { rb0 = ra0 + T0[(2 * I + 2) * 128] + T0[(2 * I + 3) * 128]; rb1 = ra1 + T0[(2 * I + 2) * 128 + 1] + T0[(2 * I + 3) * 128 + 1]; }
        if (I < 1) { rc0 = rb0 + T0[4 * 128] + T0[5 * 128]; rc1 = rb1 + T0[4 * 128 + 1] + T0[5 * 128 + 1]; }
#pragma unroll
        for (int jj = 0; jj < 8; ++jj) {
            const int i = tg * 8 + jj;
            const float bs0 = o0 + bcl[jj][0], bs1 = o1 + bcl[jj][1];
            const float qa = bflo(qw[jj]), qb2 = bfhi(qw[jj]);
            const float q0 = qa * frcp_(1.f + __expf(-qa)), q1 = qb2 * frcp_(1.f + __expf(-qb2));
            *(unsigned*)(Qb + i * 136 + 2 * dp) = cvt_pk_bf16(q0 * __expf(B0 + bs0), q1 * __expf(B1 + bs1));
            *(unsigned*)(Qe + i * 136 + 2 * dp) = cvt_pk_bf16(q0 * __expf(fmaxf(bs0, -80.f)), q1 * __expf(fmaxf(bs1, -80.f)));
            *(unsigned*)(Ke + (8 * I * (I + 1) + i) * 136 + 2 * dp) = cvt_pk_bf16(kk[jj][0] * __expf(fminf(-bs0, 80.f)), kk[jj][1] * __expf(fminf(-bs1, 80.f)));
            if (I < 3) *(unsigned*)(Ke + (8 * (I + 1) * (I + 2) + i) * 136 + 2 * dp) = cvt_pk_bf16(kk[jj][0] * __expf(ra0 - bs0), kk[jj][1] * __expf(ra1 - bs1));
            if (I < 2) *(unsigned*)(Ke + (8 * (I + 2) * (I + 3) + i) * 136 + 2 * dp) = cvt_pk_bf16(kk[jj][0] * __expf(rb0 - bs0), kk[jj][1] * __expf(rb1 - bs1));
            if (I < 1) *(unsigned*)(Ke + (96 + i) * 136 + 2 * dp) = cvt_pk_bf16(kk[jj][0] * __expf(rc0 - bs0), kk[jj][1] * __expf(rc1 - bs1));
        }
    }
    __syncthreads();
    const int wi = wave >> 2, wc = wave & 3;
    f32x4 acc[2][2];
#pragma unroll
    for (int it = 0; it < 2; ++it)
#pragma unroll
        for (int et = 0; et < 2; ++et) { acc[it][et] = (f32x4){0.f, 0.f, 0.f, 0.f};
            acc[it][et] = mma_tile<true>(Qb + (wi * 32 + it * 16) * 136, 136, Ss + (wc * 32 + et * 16) * 136, 136, 4, acc[it][et], lane); }
#pragma unroll
    for (int tt = 0; tt < 2; ++tt) {
        const int tix = wave * 2 + tt, I = tix >> 2, J = tix & 3;
        f32x4 a = (f32x4){0.f, 0.f, 0.f, 0.f};
        if (J <= I) a = mma_tile<true>(Qe + (I * 16) * 136, 136, Ke + (8 * I * (I + 1) + J * 16) * 136, 136, 4, a, lane);
        const int i = I * 16 + fr, j0 = J * 16 + fq * 4;
        float pv[4];
#pragma unroll
        for (int jj = 0; jj < 4; ++jj) pv[jj] = (J <= I && j0 + jj <= i) ? a[jj] : 0.f;
        u32x2 w; w.x = cvt_pk_bf16(pv[0], pv[1]); w.y = cvt_pk_bf16(pv[2], pv[3]); *(u32x2*)(Ps + i * 72 + j0) = w;
    }
    __syncthreads();
    {
        LAS unsigned char* l3 = (LAS unsigned char*)lds;
#pragma unroll
        for (int ks = 0; ks < 2; ++ks) {
            bf16x8 pa[2], vb[2];
#pragma unroll
            for (int it = 0; it < 2; ++it) pa[it] = row_frag_perm(Ps, 72, wi * 32 + it * 16, ks * 32, fr, fq);
#pragma unroll
            for (int et = 0; et < 2; ++et) vb[et] = tr_frag_perm(l3 + 117248, ks * 32, wc * 32 + et * 16, 144, fr, fq);
#pragma unroll
            for (int it = 0; it < 2; ++it)
#pragma unroll
                for (int et = 0; et < 2; ++et) acc[it][et] = __builtin_amdgcn_mfma_f32_16x16x32_bf16(vb[et], pa[it], acc[it][et], 0, 0, 0);
        }
    }
#pragma unroll
    for (int it = 0; it < 2; ++it) {
        float s2 = 0.f;
#pragma unroll
        for (int t = 0; t < 2; ++t)
#pragma unroll
            for (int j = 0; j < 4; ++j) { const float v = acc[it][t][j]; s2 += v * v; }
        s2 += __shfl_xor(s2, 16); s2 += __shfl_xor(s2, 32);
        if (fq == 0) ST[(wi * 32 + it * 16 + fr) * 4 + wc] = s2;
    }
    __syncthreads();
    bf16_t* ho = (bf16_t*)(p.ws + WS_BOUT) + (size_t)2 * NTOK * 1024;
    const float* hn = p.hgrn_norm + (size_t)layer * 1024 + h * 128;
#pragma unroll
    for (int it = 0; it < 2; ++it) {
        const int i = wi * 32 + it * 16 + fr;
        const float s2 = ST[i * 4] + ST[i * 4 + 1] + ST[i * 4 + 2] + ST[i * 4 + 3];
        const float rstd = __builtin_amdgcn_rsqf(s2 * (1.f / 128.f) + EPS);
        const size_t tok = t0 + i;
#pragma unroll
        for (int et = 0; et < 2; ++et) {
            const int e = wc * 32 + et * 16 + fq * 4;
            const u32x2 g = *(const u32x2*)(projA + tok * PA + C_HG + h * 128 + e);
            const f32x4 nn = *(const f32x4*)(hn + e);
            const f32x4 v = acc[it][et];
            u32x2 w; w.x = cvt_pk_bf16(v[0] * rstd * nn[0] * siluf_(bflo(g.x)), v[1] * rstd * nn[1] * siluf_(bfhi(g.x)));
            w.y = cvt_pk_bf16(v[2] * rstd * nn[2] * siluf_(bflo(g.y)), v[3] * rstd * nn[3] * siluf_(bfhi(g.y)));
            *(u32x2*)(ho + tok * 1024 + h * 128 + e) = w;
        }
    }
    __syncthreads();
}

__device__ __forceinline__ void m3_moba(const Params& p, unsigned char* lds, int item) {
    const int tid = tid_fresh(), wave = tid >> 6, lane = tid & 63, fr = lane & 15, fq = lane >> 4;
    const int bh = item & 31, qb = 15 - (item >> 5), b = bh >> 3, h = bh & 7;
    const bf16_t* projA = (const bf16_t*)(p.ws + WS_PROJA);
    const size_t tb = (size_t)b * SEQ;
    const int q0 = qb * 256;
    bf16_t* Qs = (bf16_t*)lds;
    float* KM = (float*)(lds + 69632);
    int* SEL = (int*)(lds + 77824);
    constexpr int KVB = 78912 + 1024, KVSZ = 17408 + 18432;
    stage_copy(projA + (tb + q0) * PA + C_MQ + h * 128, PA, 256, 128, Qs, 136, tid);
    { const float* km = (const float*)(p.ws + WS_KMEAN) + (size_t)bh * 2048; for (int i = tid; i < 2048; i += 512) KM[i] = km[i]; }
    if (tid == 0) SEL[256] = 0;
    __syncthreads();
    if (tid < 256) {
        float best0 = -INFINITY, best1 = -INFINITY, best2 = -INFINITY; int i0 = -1, i1 = -1, i2 = -1;
        for (int blk = 0; blk < qb; ++blk) {
            float sa = 0.f;
            for (int dd = 0; dd < 128; dd += 8) { const u32x4 qv = *(const u32x4*)(Qs + tid * 136 + dd); const float* kk = KM + blk * 128 + dd;
                sa += bflo(qv.x) * kk[0] + bfhi(qv.x) * kk[1] + bflo(qv.y) * kk[2] + bfhi(qv.y) * kk[3] + bflo(qv.z) * kk[4] + bfhi(qv.z) * kk[5] + bflo(qv.w) * kk[6] + bfhi(qv.w) * kk[7]; }
            if (sa > best0) { best2 = best1; i2 = i1; best1 = best0; i1 = i0; best0 = sa; i0 = blk; }
            else if (sa > best1) { best2 = best1; i2 = i1; best1 = sa; i1 = blk; }
            else if (sa > best2) { best2 = sa; i2 = blk; }
        }
        int mask = 0; if (i0 >= 0) mask |= 1 << i0; if (i1 >= 0) mask |= 1 << i1; if (i2 >= 0) mask |= 1 << i2;
        SEL[tid] = mask; atomicOr(&SEL[256], mask);
    }
    bf16x8 qf[2][4];
#pragma unroll
    for (int gi = 0; gi < 2; ++gi)
#pragma unroll
        for (int ks = 0; ks < 4; ++ks) qf[gi][ks] = *(const bf16x8*)(Qs + (wave * 32 + gi * 16 + fr) * 136 + ks * 32 + fq * 8);
    __syncthreads();
    if (tid == 0) {
        const int um = SEL[256]; int n = 0;
        for (int kt = 0; kt < 4; ++kt) SEL[264 + n++] = q0 + kt * 64;
        for (int kb = 0; kb < qb; ++kb) if ((um >> kb) & 1) for (int kt = 0; kt < 4; ++kt) SEL[264 + n++] = kb * 256 + kt * 64;
        SEL[257] = n;
    }
    __syncthreads();
    const int ntl = SEL[257];
    int mysel[2], qpos[2];
#pragma unroll
    for (int gi = 0; gi < 2; ++gi) { mysel[gi] = SEL[wave * 32 + gi * 16 + fr]; qpos[gi] = q0 + wave * 32 + gi * 16 + fr; }
    const float sl2 = 0.08838834764831845f * 1.4426950408889634f;
    float mneg[2] = {0.f, 0.f}, lrun[2] = {0.f, 0.f};
    f32x4 o[2][8];
#pragma unroll
    for (int gi = 0; gi < 2; ++gi)
#pragma unroll
        for (int et = 0; et < 8; ++et) o[gi][et] = (f32x4){0.f, 0.f, 0.f, 0.f};
    const int r0 = tid >> 4, c0 = tid & 15;
    const bf16_t* kg = projA + tb * PA + C_MK + h * 128 + c0 * 8;
    const bf16_t* vg = projA + tb * PA + C_MV + h * 128 + c0 * 8;
    u32x4 kr0, kr1, vr0, vr1;
    { const int key0 = SEL[264];
      kr0 = *(const u32x4*)(kg + (size_t)(key0 + r0) * PA); kr1 = *(const u32x4*)(kg + (size_t)(key0 + r0 + 32) * PA);
      vr0 = *(const u32x4*)(vg + (size_t)(key0 + r0) * PA); vr1 = *(const u32x4*)(vg + (size_t)(key0 + r0 + 32) * PA);
      bf16_t* Kb = (bf16_t*)(lds + KVB); bf16_t* Vb = (bf16_t*)(lds + KVB + 17408);
      *(u32x4*)(Kb + r0 * 136 + c0 * 8) = kr0; *(u32x4*)(Kb + (r0 + 32) * 136 + c0 * 8) = kr1;
      *(u32x4*)(Vb + r0 * 144 + c0 * 8) = vr0; *(u32x4*)(Vb + (r0 + 32) * 144 + c0 * 8) = vr1; }
    __syncthreads();
    for (int t = 0; t < ntl; ++t) {
        const int key0 = SEL[264 + t];
        const bool more = t + 1 < ntl;
        if (more) { const int kn = SEL[264 + t + 1];
            kr0 = *(const u32x4*)(kg + (size_t)(kn + r0) * PA); kr1 = *(const u32x4*)(kg + (size_t)(kn + r0 + 32) * PA);
            vr0 = *(const u32x4*)(vg + (size_t)(kn + r0) * PA); vr1 = *(const u32x4*)(vg + (size_t)(kn + r0 + 32) * PA); }
        const bf16_t* Kb = (const bf16_t*)(lds + KVB + (t & 1) * KVSZ); const bf16_t* Vb = Kb + 17408 / 2;
        const bool own = key0 >= q0; const int kb = key0 >> 8;
        if (!(own && key0 > q0 + wave * 32 + 31)) {
            f32x4 s[2][4];
            {
                bf16x8 kf[4][4];
#pragma unroll
                for (int nt = 0; nt < 4; ++nt)
#pragma unroll
                    for (int ks = 0; ks < 4; ++ks) kf[nt][ks] = *(const bf16x8*)(Kb + (nt * 16 + fr) * 136 + ks * 32 + fq * 8);
                __builtin_amdgcn_sched_barrier(0);
#pragma unroll
                for (int nt = 0; nt < 4; ++nt) { s[0][nt] = (f32x4){0.f, 0.f, 0.f, 0.f}; s[1][nt] = (f32x4){0.f, 0.f, 0.f, 0.f}; }
#pragma unroll
                for (int ks = 0; ks < 4; ++ks)
#pragma unroll
                    for (int nt = 0; nt < 4; ++nt) {
                        s[0][nt] = __builtin_amdgcn_mfma_f32_16x16x32_bf16(kf[nt][ks], qf[0][ks], s[0][nt], 0, 0, 0);
                        s[1][nt] = __builtin_amdgcn_mfma_f32_16x16x32_bf16(kf[nt][ks], qf[1][ks], s[1][nt], 0, 0, 0); }
            }
            bf16x8 pf[2][2];
#pragma unroll
            for (int gi = 0; gi < 2; ++gi) {
                if (t == 0) {
                    float mt = -INFINITY;
#pragma unroll
                    for (int nt = 0; nt < 4; ++nt)
#pragma unroll
                        for (int j = 0; j < 4; ++j) { const int key = key0 + nt * 16 + fq * 4 + j; mt = fmaxf(mt, key <= qpos[gi] ? s[gi][nt][j] * sl2 : -INFINITY); }
                    mt = fmaxf(mt, __shfl_xor(mt, 16)); mt = fmaxf(mt, __shfl_xor(mt, 32));
                    mneg[gi] = -mt;
                }
                float ls = 0.f;
                if (own) {
#pragma unroll
                    for (int nt = 0; nt < 4; ++nt)
#pragma unroll
                        for (int j = 0; j < 4; ++j) { const int key = key0 + nt * 16 + fq * 4 + j;
                            const float pv = __builtin_amdgcn_exp2f(key <= qpos[gi] ? __builtin_fmaf(s[gi][nt][j], sl2, mneg[gi]) : -INFINITY); s[gi][nt][j] = pv; ls += pv; }
                } else {
                    const float bias = ((mysel[gi] >> kb) & 1) ? mneg[gi] : -1e30f;
#pragma unroll
                    for (int nt = 0; nt < 4; ++nt)
#pragma unroll
                        for (int j = 0; j < 4; ++j) { const float pv = __builtin_amdgcn_exp2f(__builtin_fmaf(s[gi][nt][j], sl2, bias)); s[gi][nt][j] = pv; ls += pv; }
                }
                lrun[gi] += ls;
#pragma unroll
                for (int s2 = 0; s2 < 2; ++s2) { u32x4 pw; pw.x = cvt_pk_bf16(s[gi][2 * s2][0], s[gi][2 * s2][1]); pw.y = cvt_pk_bf16(s[gi][2 * s2][2], s[gi][2 * s2][3]);
                    pw.z = cvt_pk_bf16(s[gi][2 * s2 + 1][0], s[gi][2 * s2 + 1][1]); pw.w = cvt_pk_bf16(s[gi][2 * s2 + 1][2], s[gi][2 * s2 + 1][3]); pf[gi][s2] = __builtin_bit_cast(bf16x8, pw); }
            }
#pragma unroll
            for (int s2 = 0; s2 < 2; ++s2) {
                LAS unsigned char* vbase = (LAS unsigned char*)lds + KVB + (t & 1) * KVSZ + 17408;
                bf16x8 vf[8];
#pragma unroll
                for (int et = 0; et < 8; ++et) {
                    const int voff = ((s2 * 32 + fq * 4 + (fr >> 2)) * 144 + et * 16 + (fr & 3) * 4) * 2;
                    const s16x4 lo = __builtin_amdgcn_ds_read_tr16_b64_v4i16((LAS s16x4*)(vbase + voff));
                    const s16x4 hi = __builtin_amdgcn_ds_read_tr16_b64_v4i16((LAS s16x4*)(vbase + voff + 16 * 144 * 2));
                    vf[et] = __builtin_shufflevector(lo, hi, 0, 1, 2, 3, 4, 5, 6, 7);
                }
                __builtin_amdgcn_sched_barrier(0);
#pragma unroll
                for (int et = 0; et < 8; ++et) {
                    o[0][et] = __builtin_amdgcn_mfma_f32_16x16x32_bf16(vf[et], pf[0][s2], o[0][et], 0, 0, 0);
                    o[1][et] = __builtin_amdgcn_mfma_f32_16x16x32_bf16(vf[et], pf[1][s2], o[1][et], 0, 0, 0);
                }
            }
        }
        if (more) { bf16_t* Kn = (bf16_t*)(lds + KVB + ((t + 1) & 1) * KVSZ); bf16_t* Vn = Kn + 17408 / 2;
            *(u32x4*)(Kn + r0 * 136 + c0 * 8) = kr0; *(u32x4*)(Kn + (r0 + 32) * 136 + c0 * 8) = kr1;
            *(u32x4*)(Vn + r0 * 144 + c0 * 8) = vr0; *(u32x4*)(Vn + (r0 + 32) * 144 + c0 * 8) = vr1; }
        __syncthreads();
    }
    bf16_t* mo = (bf16_t*)(p.ws + WS_BOUT) + (size_t)NTOK * 1024;
#pragma unroll
    for (int gi = 0; gi < 2; ++gi) {
        float l = lrun[gi]; l += __shfl_xor(l, 16); l += __shfl_xor(l, 32);
        const float inv = 1.f / l;
        const size_t tok = tb + qpos[gi];
#pragma unroll
        for (int et = 0; et < 8; ++et) {
            u32x2 w; w.x = cvt_pk_bf16(o[gi][et][0] * inv, o[gi][et][1] * inv); w.y = cvt_pk_bf16(o[gi][et][2] * inv, o[gi][et][3] * inv);
            *(u32x2*)(mo + tok * 1024 + h * 128 + et * 16 + fq * 4) = w;
        }
    }
    __syncthreads();
}

__device__ __forceinline__ void m3_phase(const Params& p, int layer, unsigned char* lds, int rep = 0, int lo = 0, int hi = 3072) {
    unsigned* ctr = (unsigned*)(p.ws + WS_CTR) + layer * 16 + rep * 4;
    int* slot = (int*)(lds + LDS_ITEM_OFF);
    for (;;) {
        if (threadIdx.x == 0) *slot = (int)atomicAdd(ctr, 1u);
        __syncthreads();
        const int it = *slot + lo;
        __syncthreads();
        if (it >= hi) break;
        if (it < 512) m3_moba(p, lds, it);
        else if (it < 1024) m3_ret(p, layer, lds, it - 512);
        else m3_hgrn(p, layer, lds, it - 1024);
    }
}

__device__ __forceinline__ void final_norm_phase(const Params& p) {
    const int tid = tid_fresh(), wave = tid >> 6, lane = tid & 63;
    const int gw = blockIdx.x * 8 + wave, ngw = gridDim.x * 8;
    for (int r = gw; r < NTOK; r += ngw) {
        f32x4* xr = (f32x4*)(p.out + (size_t)r * DM) + lane;
        f32x4 v[8]; float s = 0.f;
#pragma unroll
        for (int j = 0; j < 8; ++j) { v[j] = xr[64 * j]; s += (v[j].x * v[j].x + v[j].y * v[j].y) + (v[j].z * v[j].z + v[j].w * v[j].w); }
        const float rstd = 1.f / sqrtf(wave_sum(s) * (1.f / DM) + EPS);
#pragma unroll
        for (int j = 0; j < 8; ++j) { const f32x4 gg = *((const f32x4*)p.final_norm + lane + 64 * j); f32x4 o = v[j] * rstd * gg;
            xr[64 * j] = o; }
    }
}


#define XB_TMO      128
#define XB_XCNT(j)  (256  + 64 * (j))
#define XB_XSUB(j)  (1280 + 64 * (j))
#define XB_XGEN(j)  (2304 + 64 * (j))
#define XB_TOP      3328
#define XB_TOPGEN   3392
#define XCD_BAR_WORDS 3456
#define XB_SPIN_CAP (1u << 18)
__device__ __forceinline__ unsigned xb_ld(unsigned* p)              { return __hip_atomic_load(p, __ATOMIC_RELAXED, __HIP_MEMORY_SCOPE_AGENT); }
__device__ __forceinline__ unsigned xb_add(unsigned* p, unsigned v) { return __hip_atomic_fetch_add(p, v, __ATOMIC_RELAXED, __HIP_MEMORY_SCOPE_AGENT); }
__device__ __forceinline__ unsigned xb_xcc_id() { return (unsigned)__builtin_amdgcn_s_getreg((3 << 11) | 20) & 0xFu; }
#define XB_SPIN(cond, bar) do { unsigned _sp = 0; while (cond) { __builtin_amdgcn_s_sleep(1); \
    if ((++_sp & 255u) == 0u) { if (xb_ld(&(bar)[XB_TMO])) break; if (_sp > XB_SPIN_CAP) { atomicAdd(&(bar)[XB_TMO], 1u); break; } } } } while (0)
struct XcdBarrier { unsigned* bar; unsigned x; volatile LAS unsigned* st; };
__device__ __forceinline__ XcdBarrier xcd_barrier_post(unsigned* bar, volatile LAS unsigned* st) {
    XcdBarrier b; b.bar = bar; b.x = xb_xcc_id(); b.st = st;
    if (threadIdx.x == 0) (void)xb_add(&bar[XB_XCNT(b.x)], 1u);
    return b;
}
__device__ __forceinline__ void xcd_barrier_complete(unsigned* bar, unsigned x, unsigned& nloc, unsigned& nx) {
    const unsigned G = gridDim.x * gridDim.y * gridDim.z;
    unsigned sum, cnt, mine, sp = 0u;
    for (;;) {
        sum = 0u; cnt = 0u; mine = 0u;
#pragma unroll
        for (unsigned j = 0; j < 16; ++j) { const unsigned c = xb_ld(&bar[XB_XCNT(j)]); sum += c; cnt += (c > 0u) ? 1u : 0u; mine = (j == x) ? c : mine; }
        if (sum == G) break;
        __builtin_amdgcn_s_sleep(1);
        if ((++sp & 255u) == 0u) { if (xb_ld(&bar[XB_TMO])) break; if (sp > XB_SPIN_CAP) { atomicAdd(&bar[XB_TMO], 1u); break; } }
    }
    nloc = mine > 0u ? mine : 1u; nx = cnt > 0u ? cnt : 1u;
}
__device__ __forceinline__ void xcd_barrier(const XcdBarrier& b) {
    asm volatile("s_waitcnt vmcnt(0)" ::: "memory");
    __syncthreads();
    if (threadIdx.x == 0) {
        unsigned* bar = b.bar;
        __builtin_amdgcn_s_waitcnt(0);
        unsigned nloc = b.st[0], nx = b.st[1];
        if (nloc == 0u) { xcd_barrier_complete(bar, b.x, nloc, nx); b.st[0] = nloc; b.st[1] = nx; }
        const unsigned old = xb_add(&bar[XB_XSUB(b.x)], 1u);
        const unsigned gen = old / nloc;
        if (old + 1u == (gen + 1u) * nloc) {
            __builtin_amdgcn_fence(__ATOMIC_RELEASE, "agent");
            asm volatile("s_waitcnt vmcnt(0)" ::: "memory");
            const unsigned og = xb_add(&bar[XB_TOP], 1u);
            const unsigned tg = og / nx;
            if (og + 1u == (tg + 1u) * nx) xb_add(&bar[XB_TOPGEN], 1u);
            else XB_SPIN(xb_ld(&bar[XB_TOPGEN]) == tg, bar);
            __builtin_amdgcn_fence(__ATOMIC_ACQUIRE, "agent");
            xb_add(&bar[XB_XGEN(b.x)], 1u);
            asm volatile("s_waitcnt vmcnt(0)" ::: "memory");
        } else {
            XB_SPIN(xb_ld(&bar[XB_XGEN(b.x)]) == gen, bar);
            __builtin_amdgcn_fence(__ATOMIC_ACQUIRE, "agent");
            asm volatile("s_waitcnt vmcnt(0)" ::: "memory");
        }
    }
    __syncthreads();
}

__global__ void __launch_bounds__(512, 2) fwd_megakernel(Params p) {
    extern __shared__ __attribute__((aligned(16))) unsigned char smem[];
    cg::grid_group grid = cg::this_grid();
    unsigned char* ws = p.ws;
    LAS unsigned char* lds3 = (LAS unsigned char*)smem;
    const int G = gridDim.x, c = blockIdx.x;
    prep_phase(p, 0, smem, p.x, p.norm_mix);
    { volatile LAS unsigned* stz = (volatile LAS unsigned*)(lds3 + LDS_BYTES - 32); if (threadIdx.x == 0) { stz[0] = 0u; stz[1] = 0u; } }
    grid.sync();
    const XcdBarrier xb = xcd_barrier_post((unsigned*)(ws + WS_XBAR), (volatile LAS unsigned*)(lds3 + LDS_BYTES - 32));
    for (int layer = 0; layer < DEPTH; ++layer) {
        const float* xin = layer == 0 ? p.x : p.out;
        {
            pg8::Sched S; S.init(NTOK, INC, DM, G, c, 1); S.A0 = (const bf16_t*)(ws + WS_HB); S.B0 = (const bf16_t*)(ws + WS_WIN); S.zsA = 0; S.zsB = 0;
            EpiIn E; E.projA = (bf16_t*)(ws + WS_PROJA); E.gates = (bf16_t*)(ws + WS_GATES); E.ropeR = (const float*)(ws + WS_ROPER); E.ropeM = (const float*)(ws + WS_ROPEM);
            pg8::gemm_phase(lds3, S, E);
        }
        xcd_barrier(xb);
        m1_phase(p, layer, smem);
        xcd_barrier(xb);
        m2_phase(p);
        xcd_barrier(xb);
        m3_phase(p, layer, smem);
        xcd_barrier(xb);
        {
            pg8::Sched S; S.init(NTOK, DM, 1024, G, c, 3);
            S.A0 = (const bf16_t*)(ws + WS_BOUT); S.zsA = (size_t)NTOK * 1024; S.B0 = (const bf16_t*)(ws + WS_WBR); S.zsB = E_WBR;
            EpiBr E; E.gates = (const bf16_t*)(ws + WS_GATES); E.mixb = (bf16_t*)(ws + WS_MIXB);
            pg8::gemm_phase(lds3, S, E);
        }
        xcd_barrier(xb);
        {
            pg8::Sched S; S.init(NTOK, DM, DM, G, c, 1); S.A0 = (const bf16_t*)(ws + WS_MIXB); S.B0 = (const bf16_t*)(ws + WS_WOUT); S.zsA = 0; S.zsB = 0;
            EpiRes E; E.xin = xin; E.xout = p.out;
            pg8::gemm_phase(lds3, S, E);
        }
        xcd_barrier(xb);
        {
            const int tq = tid_fresh(); const int wave = tq >> 6, lane = tq & 63;
            rmsnorm_rows_bf16(p.out, p.norm_ffn + (size_t)layer * DM, (bf16_t*)(ws + WS_HB), c * 8 + wave, G * 8, lane);
        }
        xcd_barrier(xb);
        {
            pg8::Sched S; S.init(NTOK, 2 * FH, DM, G, c, 1); S.A0 = (const bf16_t*)(ws + WS_HB); S.B0 = (const bf16_t*)(ws + WS_WGU); S.zsA = 0; S.zsB = 0;
            EpiGU E; E.ffh = (bf16_t*)(ws + WS_FFH);
            pg8::gemm_phase(lds3, S, E);
        }
        xcd_barrier(xb);
        {
            pg8::Sched S; S.init(NTOK, DM, FH, G, c, 1); S.A0 = (const bf16_t*)(ws + WS_FFH); S.B0 = (const bf16_t*)(ws + WS_WDN); S.zsA = 0; S.zsB = 0;
            EpiRes E; E.xin = p.out; E.xout = p.out;
            pg8::gemm_phase(lds3, S, E);
        }
        xcd_barrier(xb);
        if (layer + 1 < DEPTH) { prep_phase(p, layer + 1, smem, p.out, p.norm_mix + (size_t)(layer + 1) * DM); xcd_barrier(xb);
        }
    }
    final_norm_phase(p);
}

extern "C" void kernel_launch(void* const* d_in, const int* in_sizes, int n_in, void* d_out, int out_size, void* d_ws, size_t ws_size, hipStream_t stream) {
    static int grid_blocks = 0;
    if (grid_blocks == 0) {
        if (n_in != 15 || out_size != NTOK * DM || ws_size < WS_END) { fprintf(stderr, "kernel_launch: unexpected shapes (n_in %d out %d ws %zu need %zu)\n", n_in, out_size, ws_size, (size_t)WS_END); grid_blocks = -1; return; }
        int dev = 0, cus = 0, per_cu = 0;
        hipGetDevice(&dev);
        hipDeviceGetAttribute(&cus, hipDeviceAttributeMultiprocessorCount, dev);
        if (hipFuncSetAttribute((const void*)fwd_megakernel, hipFuncAttributeMaxDynamicSharedMemorySize, LDS_BYTES) != hipSuccess) { fprintf(stderr, "kernel_launch: hipFuncSetAttribute failed\n"); }
        if (hipOccupancyMaxActiveBlocksPerMultiprocessor(&per_cu, (const void*)fwd_megakernel, 512, LDS_BYTES) != hipSuccess || per_cu < 1) { fprintf(stderr, "kernel_launch: occupancy query gave %d\n", per_cu); per_cu = 1; }
        (void)hipGetLastError();
        grid_blocks = cus;
        if (grid_blocks > 256) grid_blocks = 256;
    }
    if (grid_blocks < 0) return;
    Params p{};
    p.x = (const float*)d_in[0]; p.lb = (const float*)d_in[1]; p.norm_mix = (const float*)d_in[2]; p.w_in = (const float*)d_in[3]; p.ret_norm = (const float*)d_in[4]; p.hgrn_norm = (const float*)d_in[5];
    p.w_br[0] = (const float*)d_in[6]; p.w_br[1] = (const float*)d_in[7]; p.w_br[2] = (const float*)d_in[8]; p.w_out = (const float*)d_in[9]; p.norm_ffn = (const float*)d_in[10];
    p.w_gate = (const float*)d_in[11]; p.w_up = (const float*)d_in[12]; p.w_down = (const float*)d_in[13]; p.final_norm = (const float*)d_in[14];
    p.out = (float*)d_out; p.ws = (unsigned char*)d_ws;
    void* args[] = {&p};
    hipError_t e = hipLaunchCooperativeKernel((const void*)fwd_megakernel, dim3(grid_blocks), dim3(512), args, LDS_BYTES, stream);
    if (e != hipSuccess) fprintf(stderr, "cooperative launch failed: %s (grid %d)\n", hipGetErrorString(e), grid_blocks);
}
```
